# Optimizing an MI355X kernel written in HIP

```python
import math
import jax, jax.numpy as jnp
from jax import lax
import numpy as np

D_MODEL = 2048
BATCH = 32
SEQ = 256
DEPTH = 2
DEC_BATCH = 2
DEC_SEQ = 1024
PAST_LEN = 512

GRID_W = 64
DH = 128
H_A = 8
W_A = H_A * DH
WIN_H = 8
WIN_W = 16
H_B = 8
W_B = H_B * DH
ML_CHUNK = 128
H_C = 8
DQK = 64
W_CQK = H_C * 2 * DQK
W_CV = H_C * DH
ROPE_THETA = 10000.0
G_D = 8
SG_CHUNK = 128
W_D = 1024
SG_W = W_D // G_D
D_MIX = W_A + W_B
D_FF = 5632
IN_EVEN = 3 * W_A + 4 * W_B + 4 * H_B
IN_ODD = 2 * W_CQK + W_CV + 2 * W_D
N_EVEN = (DEPTH + 1) // 2
N_ODD = DEPTH // 2
Q_BLOCK = 128
EPS = 1e-6

kernel_name = 'hybrid_natten_mlstm_diffattn_sgu_dit_step'


def _rms(x, g):
    xf = x.astype(jnp.float32)
    y = xf * lax.rsqrt(jnp.mean(xf * xf, axis=-1, keepdims=True) + EPS)
    return (y * g.astype(jnp.float32)).astype(x.dtype)


def _modulation(cond, w_mod, b_mod):
    m = jax.nn.silu(cond) @ w_mod + b_mod
    return jnp.split(m[:, None, :], 6, axis=-1)


def _lambda_init(layer):
    return 0.8 - 0.6 * math.exp(-0.3 * layer)


def _axial_rope(x):
    S = x.shape[1]
    t = jnp.arange(S)
    pos = jnp.stack([t // GRID_W, t % GRID_W], axis=-1).astype(jnp.float32)
    half = x.shape[-1] // 2
    inv = ROPE_THETA ** (-jnp.arange(0, half, 2, dtype=jnp.float32) / half)
    ang = pos[:, :, None] * inv
    shape = (1, S) + (1,) * (x.ndim - 3) + (2, half // 2)
    cos = jnp.cos(ang).reshape(shape)
    sin = jnp.sin(ang).reshape(shape)
    xf = x.astype(jnp.float32).reshape(x.shape[:-1] + (2, half))
    x1, x2 = xf[..., :half // 2], xf[..., half // 2:]
    out = jnp.concatenate([x1 * cos - x2 * sin, x2 * cos + x1 * sin], axis=-1)
    return out.reshape(x.shape).astype(x.dtype)


def _sweep(fn, q):
    B, H, Sq = q.shape[:3]
    nb = Sq // Q_BLOCK
    qb = jnp.moveaxis(q.reshape((B, H, nb, Q_BLOCK) + q.shape[3:]), 2, 0)
    out = lax.map(fn, qb)
    return jnp.moveaxis(out, 0, 2).reshape((B, H, Sq) + out.shape[4:])


def _softmax_attend(q, k, v):
    scale = q.shape[-1] ** -0.5
    def blk(qb):
        s = jnp.einsum('bhqd,bhkd->bhqk', qb, k).astype(jnp.float32) * scale
        p = jax.nn.softmax(s, axis=-1).astype(v.dtype)
        return jnp.einsum('bhqk,bhkd->bhqd', p, v)
    return _sweep(blk, q)


def _diff_attend(q, k, v, lam):
    scale = q.shape[-1] ** -0.5
    def blk(qb):
        s = jnp.einsum('bhqmd,bhkmd->bhmqk', qb, k).astype(jnp.float32) * scale
        p = jax.nn.softmax(s, axis=-1)
        a = (p[:, :, 0] - lam * p[:, :, 1]).astype(v.dtype)
        return jnp.einsum('bhqk,bhkd->bhqd', a, v)
    return _sweep(blk, q)


def _neighbourhood_attend(q, k, v, k_ctx, v_ctx, rpb):
    B, H, S, dh = q.shape
    rows = S // GRID_W
    kh = min(WIN_H, rows)
    r = np.arange(rows)
    row0 = np.clip(r - kh // 2, 0, rows - kh)
    band = row0[:, None] + np.arange(kh)[None, :]
    qc = np.arange(GRID_W)
    col0 = np.clip(qc - WIN_W // 2, 0, GRID_W - WIN_W)
    kc = np.arange(GRID_W)
    col_ok = (kc[None, :] >= col0[:, None]) & (kc[None, :] < col0[:, None] + WIN_W)
    dr_idx = band - r[:, None] + WIN_H - 1
    dc_idx = np.clip(kc[None, :] - qc[:, None] + WIN_W - 1, 0, 2 * WIN_W - 2)
    bias = rpb[:, dr_idx[:, None, :, None], dc_idx[None, :, None, :]]
    bias = jnp.where(col_ok[None, None, :, None, :], bias.astype(jnp.float32), -jnp.inf)
    qg = q.reshape(B, H, rows, GRID_W, dh)
    kb = k.reshape(B, H, rows, GRID_W, dh)[:, :, band]
    vb = v.reshape(B, H, rows, GRID_W, dh)[:, :, band]
    scale = dh ** -0.5
    n_loc = kh * GRID_W
    s_loc = jnp.einsum('bhrqd,bhrikd->bhrqik', qg, kb).astype(jnp.float32) * scale + bias[None]
    s_ctx = jnp.einsum('bhrqd,bhld->bhrql', qg, k_ctx).astype(jnp.float32) * scale
    s = jnp.concatenate([s_loc.reshape(B, H, rows, GRID_W, n_loc), s_ctx], axis=-1)
    p = jax.nn.softmax(s, axis=-1).astype(v.dtype)
    p_loc = p[..., :n_loc].reshape(B, H, rows, GRID_W, kh, GRID_W)
    out = (jnp.einsum('bhrqik,bhrikd->bhrqd', p_loc, vb)
           + jnp.einsum('bhrql,bhld->bhrqd', p[..., n_loc:], v_ctx))
    return out.reshape(B, H, S, dh)


def _mlstm_scan(q, k, v, li, lf, C0, n0, m0):
    B, S, H, dh = q.shape
    nc = S // ML_CHUNK
    def chunks(a):
        a = jnp.moveaxis(a.reshape((B, nc, ML_CHUNK) + a.shape[2:]), 1, 0)
        return jnp.swapaxes(a, 2, 3)
    tril = jnp.tril(jnp.ones((ML_CHUNK, ML_CHUNK), dtype=bool))
    def step(carry, xs):
        C, n, m = carry
        qc, kc, vc, ic, fc = xs
        b = jnp.cumsum(fc, axis=-1)
        dmat = jnp.where(tril, b[..., :, None] - b[..., None, :] + ic[..., None, :], -jnp.inf)
        inter = b + m[..., None]
        mj = jnp.maximum(inter, jnp.max(dmat, axis=-1))
        w_in = jnp.exp(inter - mj)
        w = jnp.exp(dmat - mj[..., None]) * jnp.einsum('bhjd,bhsd->bhjs', qc, kc)
        num = w_in[..., None] * jnp.einsum('bhjd,bhde->bhje', qc, C) + jnp.einsum('bhjs,bhse->bhje', w, vc)
        den = w_in * jnp.einsum('bhjd,bhd->bhj', qc, n) + jnp.sum(w, axis=-1)
        h = num / jnp.maximum(jnp.abs(den), jnp.exp(-mj))[..., None]
        bl = b[..., -1]
        ds = bl[..., None] - b + ic
        m_new = jnp.maximum(bl + m, jnp.max(ds, axis=-1))
        a_prev = jnp.exp(bl + m - m_new)
        ws = jnp.exp(ds - m_new[..., None])
        C = a_prev[..., None, None] * C + jnp.einsum('bhs,bhsd,bhse->bhde', ws, kc, vc)
        n = a_prev[..., None] * n + jnp.einsum('bhs,bhsd->bhd', ws, kc)
        return (C, n, m_new), h
    xs = (chunks(q), chunks(k), chunks(v), chunks(li), chunks(lf))
    (C, n, m), h = lax.scan(step, (C0, n0, m0), xs)
    h = jnp.moveaxis(jnp.swapaxes(h, 2, 3), 0, 1).reshape(B, S, H, dh)
    return h, C, n, m


def _mlstm_bidir(q, k, v, gates, C0, n0, m0):
    f32 = lambda a: a.astype(jnp.float32)
    q, k, v, gates = f32(q), f32(k), f32(v), f32(gates)
    li_f, lf_f = gates[:, :, 0], jax.nn.log_sigmoid(gates[:, :, 1])
    li_b, lf_b = gates[:, :, 2], jax.nn.log_sigmoid(gates[:, :, 3])
    h_f, Cf, nf, mf = _mlstm_scan(q, k, v, li_f, lf_f, f32(C0[:, 0]), f32(n0[:, 0]), f32(m0[:, 0]))
    rev = lambda a: jnp.flip(a, axis=1)
    h_b, Cb, nb, mb = _mlstm_scan(rev(q), rev(k), rev(v), rev(li_b), rev(lf_b),
                                  f32(C0[:, 1]), f32(n0[:, 1]), f32(m0[:, 1]))
    return (h_f + rev(h_b), jnp.stack([Cf, Cb], axis=1), jnp.stack([nf, nb], axis=1), jnp.stack([mf, mb], axis=1))


def _even_mixer(h, w_in, na_gq, na_gk, na_rpb, ml_b, ml_g, cache=None):
    B, S, _ = h.shape
    cuts = [W_A, 2 * W_A, 3 * W_A, 3 * W_A + W_B, 3 * W_A + 2 * W_B, 3 * W_A + 3 * W_B, 3 * W_A + 4 * W_B]
    qa, ka, va, qb, kb, vb, ob, gates = jnp.split(h @ w_in, cuts, axis=-1)
    qa = _rms(qa.reshape(B, S, H_A, DH), na_gq).transpose(0, 2, 1, 3)
    ka = _rms(ka.reshape(B, S, H_A, DH), na_gk).transpose(0, 2, 1, 3)
    va = va.reshape(B, S, H_A, DH).transpose(0, 2, 1, 3)
    qb = qb.reshape(B, S, H_B, DH)
    kb = kb.reshape(B, S, H_B, DH) * (DH ** -0.5)
    vb = vb.reshape(B, S, H_B, DH)
    gates = gates.reshape(B, S, 4, H_B) + ml_b.reshape(4, H_B)
    if cache is None:
        out_a = _softmax_attend(qa, ka, va)
        C0 = jnp.zeros((B, 2, H_B, DH, DH), jnp.float32)
        n0 = jnp.zeros((B, 2, H_B, DH), jnp.float32)
        m0 = jnp.zeros((B, 2, H_B), jnp.float32)
    else:
        k_ctx, v_ctx, C0, n0, m0 = cache
        out_a = _neighbourhood_attend(qa, ka, va, k_ctx, v_ctx, na_rpb)
    hm, C1, n1, m1 = _mlstm_bidir(qb, kb, vb, gates, C0, n0, m0)
    out_b = jax.nn.sigmoid(ob) * _rms(hm.astype(h.dtype), ml_g.reshape(H_B, DH)).reshape(B, S, W_B)
    out = jnp.concatenate([out_a.transpose(0, 2, 1, 3).reshape(B, S, W_A), out_b], axis=-1)
    ctx = (ka, va, C1.astype(h.dtype), n1.astype(h.dtype), m1.astype(h.dtype)) if cache is None else ()
    return out, ctx


def _odd_mixer(h, w_in, gq, gk, lam_vec, g_out, sg_g, sg_w, sg_b, lam_init, cache=None):
    B, S, _ = h.shape
    cuts = [W_CQK, 2 * W_CQK, 2 * W_CQK + W_CV, 2 * W_CQK + W_CV + W_D]
    q, k, v, u, vd = jnp.split(h @ w_in, cuts, axis=-1)
    q = _rms(q.reshape(B, S, H_C, 2, DQK), gq)
    k = _rms(k.reshape(B, S, H_C, 2, DQK), gk)
    v = v.reshape(B, S, H_C, DH).transpose(0, 2, 1, 3)
    lam = (jnp.exp(jnp.sum(lam_vec[0] * lam_vec[1])) - jnp.exp(jnp.sum(lam_vec[2] * lam_vec[3])) + lam_init).astype(jnp.float32)
    if cache is None:
        q = q.transpose(0, 2, 1, 3, 4)
        k = k.transpose(0, 2, 1, 3, 4)
        out = _diff_attend(q, k, v, lam)
        ctx = (k, v)
    else:
        k_ctx, v_ctx = cache
        q = _axial_rope(q).transpose(0, 2, 1, 3, 4)
        k = _axial_rope(k).transpose(0, 2, 1, 3, 4)
        out = _diff_attend(q, jnp.concatenate([k, k_ctx], axis=2), jnp.concatenate([v, v_ctx], axis=2), lam)
        ctx = ()
    out_c = (_rms(out.transpose(0, 2, 1, 3), g_out.reshape(H_C, DH)) * (1.0 - lam_init)).reshape(B, S, W_CV)
    u = jax.nn.gelu(u)
    vd = _rms(jax.nn.gelu(vd), sg_g).reshape(B, S // SG_CHUNK, SG_CHUNK, G_D, SG_W)
    gate = jnp.einsum('gpt,bntgc->bnpgc', sg_w, vd) + sg_b.T[:, :, None]
    out_d = u * gate.reshape(B, S, W_D)
    return jnp.concatenate([out_c, out_d], axis=-1), ctx


def _conv_ffn(h, w_up, conv_w, conv_b, w_down):
    a = h @ w_up
    ap = jnp.pad(a, ((0, 0), (1, 1), (0, 0)))
    a = ap[:, :-2] * conv_w[0] + ap[:, 1:-1] * conv_w[1] + ap[:, 2:] * conv_w[2] + conv_b
    g, val = jnp.split(a, 2, axis=-1)
    return (jax.nn.silu(g) * val) @ w_down


def _run_trunk(x, cond, p, caches=None):
    even_out, odd_out = [], []
    for l in range(DEPTH):
        j = l // 2
        sm, cm, gm, sf, cf, gf = _modulation(cond, p['w_mod'][l], p['b_mod'][l])
        h = _rms(x, p['g_mix'][l]) * (1 + cm) + sm
        if l % 2 == 0:
            cache = None if caches is None else tuple(a[:, j] for a in caches[0])
            mix, ctx = _even_mixer(h, p['w_in_even'][j], p['na_gq'][j], p['na_gk'][j], p['na_rpb'][j],
                                   p['ml_b_gates'][j], p['ml_g_out'][j], cache)
            even_out.append(ctx)
        else:
            cache = None if caches is None else tuple(a[:, j] for a in caches[1])
            mix, ctx = _odd_mixer(h, p['w_in_odd'][j], p['diff_gq'][j], p['diff_gk'][j], p['diff_lam'][j],
                                  p['diff_g_out'][j], p['sg_g_v'][j], p['sg_w'][j], p['sg_b'][j],
                                  _lambda_init(l), cache)
            odd_out.append(ctx)
        x = x + gm * (mix @ p['w_out'][l])
        h = _rms(x, p['g_ffn'][l]) * (1 + cf) + sf
        x = x + gf * _conv_ffn(h, p['ffn_w_up'][l], p['ffn_conv_w'][l], p['ffn_conv_b'][l], p['ffn_w_down'][l])
    stack = lambda outs: [jnp.stack(t, axis=1) for t in zip(*outs)]
    return x, stack(even_out), stack(odd_out)


def setup_inputs(seed: int = 0) -> dict:
    key = jax.random.key(seed)
    keys = iter(jax.random.split(key, 64))
    def nrm(shape, scale):
        return jax.random.normal(next(keys), shape, jnp.float32) * scale
    def gain(shape):
        return 1.0 + nrm(shape, 0.02)
    f_bias = jnp.linspace(3.0, 6.0, H_B, dtype=jnp.float32)
    ml_b_gates = jnp.concatenate([nrm((N_EVEN, H_B), 0.1), f_bias + nrm((N_EVEN, H_B), 0.1),
                                  nrm((N_EVEN, H_B), 0.1), f_bias + nrm((N_EVEN, H_B), 0.1)], axis=-1)
    return {
        'x_prompt': nrm((BATCH, SEQ, D_MODEL), 1.0),
        'x_sample': nrm((DEC_BATCH, DEC_SEQ, D_MODEL), 1.0),
        'cache_na_k': nrm((DEC_BATCH, N_EVEN, H_A, PAST_LEN, DH), 1.0),
        'cache_na_v': nrm((DEC_BATCH, N_EVEN, H_A, PAST_LEN, DH), 1.0),
        'state_mlstm_C': nrm((DEC_BATCH, N_EVEN, 2, H_B, DH, DH), 0.1),
        'state_mlstm_n': nrm((DEC_BATCH, N_EVEN, 2, H_B, DH), 0.1),
        'state_mlstm_m': nrm((DEC_BATCH, N_EVEN, 2, H_B), 1.0),
        'cache_diff_k': nrm((DEC_BATCH, N_ODD, H_C, PAST_LEN, 2, DQK), 1.0),
        'cache_diff_v': nrm((DEC_BATCH, N_ODD, H_C, PAST_LEN, DH), 1.0),
        'c': nrm((DEC_BATCH, D_MODEL), 1.0),
        'c_ctx': nrm((D_MODEL,), 1.0),
        'w_mod': nrm((DEPTH, D_MODEL, 6 * D_MODEL), 0.3 * D_MODEL ** -0.5),
        'b_mod': nrm((DEPTH, 6 * D_MODEL), 0.02),
        'g_mix': gain((DEPTH, D_MODEL)),
        'g_ffn': gain((DEPTH, D_MODEL)),
        'w_out': nrm((DEPTH, D_MIX, D_MODEL), D_MIX ** -0.5),
        'w_in_even': nrm((N_EVEN, D_MODEL, IN_EVEN), D_MODEL ** -0.5),
        'na_gq': gain((N_EVEN, DH)),
        'na_gk': gain((N_EVEN, DH)),
        'na_rpb': nrm((N_EVEN, H_A, 2 * WIN_H - 1, 2 * WIN_W - 1), 0.5),
        'ml_b_gates': ml_b_gates,
        'ml_g_out': gain((N_EVEN, W_B)),
        'w_in_odd': nrm((N_ODD, D_MODEL, IN_ODD), D_MODEL ** -0.5),
        'diff_gq': gain((N_ODD, DQK)),
        'diff_gk': gain((N_ODD, DQK)),
        'diff_lam': nrm((N_ODD, 4, DQK), 0.1),
        'diff_g_out': gain((N_ODD, W_CV)),
        'sg_g_v': gain((N_ODD, W_D)),
        'sg_w': nrm((N_ODD, G_D, SG_CHUNK, SG_CHUNK), SG_CHUNK ** -0.5),
        'sg_b': 1.0 + nrm((N_ODD, G_D, SG_CHUNK), 0.02),
        'ffn_w_up': nrm((DEPTH, D_MODEL, 2 * D_FF), D_MODEL ** -0.5),
        'ffn_conv_w': nrm((DEPTH, 3, 2 * D_FF), 3 ** -0.5),
        'ffn_conv_b': nrm((DEPTH, 2 * D_FF), 0.02),
        'ffn_w_down': nrm((DEPTH, D_FF, D_MODEL), D_FF ** -0.5),
    }


def reference(x_prompt, x_sample, cache_na_k, cache_na_v, state_mlstm_C, state_mlstm_n, state_mlstm_m,
              cache_diff_k, cache_diff_v, c, c_ctx, w_mod, b_mod, g_mix, g_ffn, w_out, w_in_even,
              na_gq, na_gk, na_rpb, ml_b_gates, ml_g_out, w_in_odd, diff_gq, diff_gk, diff_lam,
              diff_g_out, sg_g_v, sg_w, sg_b, ffn_w_up, ffn_conv_w, ffn_conv_b, ffn_w_down):
    p = dict(w_mod=w_mod, b_mod=b_mod, g_mix=g_mix, g_ffn=g_ffn, w_out=w_out, w_in_even=w_in_even,
             na_gq=na_gq, na_gk=na_gk, na_rpb=na_rpb, ml_b_gates=ml_b_gates, ml_g_out=ml_g_out,
             w_in_odd=w_in_odd, diff_gq=diff_gq, diff_gk=diff_gk, diff_lam=diff_lam, diff_g_out=diff_g_out,
             sg_g_v=sg_g_v, sg_w=sg_w, sg_b=sg_b, ffn_w_up=ffn_w_up, ffn_conv_w=ffn_conv_w,
             ffn_conv_b=ffn_conv_b, ffn_w_down=ffn_w_down)
    y_prompt, even_ctx, odd_ctx = _run_trunk(x_prompt, c_ctx[None, :], p)
    na_k, na_v, mlstm_C, mlstm_n, mlstm_m = even_ctx
    diff_k, diff_v = odd_ctx
    caches = ((cache_na_k, cache_na_v, state_mlstm_C, state_mlstm_n, state_mlstm_m), (cache_diff_k, cache_diff_v))
    y_sample, _, _ = _run_trunk(x_sample, c, p, caches)
    return (y_prompt, y_sample, na_k, na_v, mlstm_C, mlstm_n, mlstm_m, diff_k, diff_v)
```

```cpp
#include <hip/hip_runtime.h>
#include <cstdio>
#include <cstdint>

#define LAS __attribute__((address_space(3)))
typedef unsigned short bf16_t;
typedef short bf16x8 __attribute__((ext_vector_type(8)));
typedef float f32x4 __attribute__((ext_vector_type(4)));
typedef float f32x2 __attribute__((ext_vector_type(2)));
typedef unsigned u32x4 __attribute__((ext_vector_type(4)));
typedef unsigned u32x2 __attribute__((ext_vector_type(2)));

constexpr int D_MODEL = 2048, NCTX = 8192, NLAT = 2048, MTOK = NCTX + NLAT;
constexpr int IN_EVEN = 7200, IN_EVEN_PAD = 7424, IN_ODD = 5120, D_FF = 5632, D_FF2 = 11264;
constexpr float EPS = 1e-6f;
constexpr float LAM_INIT1 = 0.35550906759f;

constexpr size_t MiB = 1u << 20;
constexpr size_t WS_CTL = 0, CTL_ZERO_BYTES = 1 * MiB + 600 * 1024;
constexpr size_t WS_ROWSS = 512 * 1024;
constexpr size_t WS_MOD = 1 * MiB;
constexpr size_t WS_RSF = 600 * 1024;
constexpr size_t WS_BIAS = 1 * MiB + 320 * 1024;
constexpr size_t WS_ROPE = 1 * MiB + 640 * 1024;
constexpr size_t WS_WINE = 2 * MiB;
constexpr size_t WS_WINO = 31 * MiB;
constexpr size_t WS_WOUT = 51 * MiB;
constexpr size_t WS_WUP = 67 * MiB;
constexpr size_t WS_WDN = 155 * MiB;
constexpr size_t WS_XRES = 199 * MiB;
constexpr size_t WS_H = 279 * MiB;
constexpr size_t WS_BIG = 319 * MiB;
constexpr size_t WS_PART = 319 * MiB;
constexpr size_t WS_PROJ = 319 * MiB;
constexpr size_t WS_MIX = 464 * MiB;
constexpr size_t WS_GATES = 504 * MiB;
constexpr size_t WS_ERAW = 506 * MiB;
constexpr size_t WS_ECV = 508 * MiB;
constexpr size_t WS_ACT = 539 * MiB;
constexpr size_t WS_HF = 539 * MiB;
constexpr size_t WS_HB = 579 * MiB;
constexpr size_t WS_END = 649 * MiB;
constexpr int CW_Q0 = 64, CW_Q1 = 128;
constexpr int CW_FIX = 1024;
constexpr int CW_BAR = 4096;

constexpr size_t O_Y = 0, O_NAK = 20971520, O_NAV = 29360128, O_MC = 37748736, O_MN = 46137344, O_MM = 46202880, O_DK = 46203392, O_DV = 54592000;

#ifndef DEFER_PROLOGUE
#define DEFER_PROLOGUE 1
#endif
constexpr int LDS_MISC = 151552;
constexpr int LDS_BYTES = 152576;

__device__ __forceinline__ unsigned cvt_pk_bf16(float lo, float hi) { unsigned r; asm volatile("v_cvt_pk_bf16_f32 %0, %1, %2" : "=v"(r) : "v"(lo), "v"(hi)); return r; }
__device__ __forceinline__ unsigned f2bf(float f) { return cvt_pk_bf16(f, 0.f) & 0xffffu; }
__device__ __forceinline__ float bf_lo(unsigned w) { return __uint_as_float(w << 16); }
__device__ __forceinline__ float bf_hi(unsigned w) { return __uint_as_float(w & 0xffff0000u); }
__device__ __forceinline__ void unpack8(const u32x4 w, float* f) { f[0] = bf_lo(w.x); f[1] = bf_hi(w.x); f[2] = bf_lo(w.y); f[3] = bf_hi(w.y); f[4] = bf_lo(w.z); f[5] = bf_hi(w.z); f[6] = bf_lo(w.w); f[7] = bf_hi(w.w); }
__device__ __forceinline__ u32x4 pack8(const float* f) { u32x4 w; w.x = cvt_pk_bf16(f[0], f[1]); w.y = cvt_pk_bf16(f[2], f[3]); w.z = cvt_pk_bf16(f[4], f[5]); w.w = cvt_pk_bf16(f[6], f[7]); return w; }
__device__ __forceinline__ void load8_bf(const bf16_t* p, float* f) { unpack8(*(const u32x4*)p, f); }
__device__ __forceinline__ void load8_f32(const float* p, float* f) { const f32x4 a = *(const f32x4*)p, b = *(const f32x4*)(p + 4); f[0] = a.x; f[1] = a.y; f[2] = a.z; f[3] = a.w; f[4] = b.x; f[5] = b.y; f[6] = b.z; f[7] = b.w; }
__device__ __forceinline__ void store8_f32(float* p, const float* f) { *(f32x4*)p = (f32x4){f[0], f[1], f[2], f[3]}; *(f32x4*)(p + 4) = (f32x4){f[4], f[5], f[6], f[7]}; }
__device__ __forceinline__ float wave_sum(float v) {
#pragma unroll
    for (int o = 1; o < 64; o <<= 1) v += __shfl_xor(v, o);
    return v;
}
__device__ __forceinline__ float gelu_tanh(float x) { const float y = 0.7978845608f * (x + 0.044715f * x * x * x); return x * __builtin_amdgcn_rcpf(1.f + __expf(-2.f * y)); }
__device__ __forceinline__ float sigmoidf_(float x) { return __builtin_amdgcn_rcpf(1.f + __expf(-x)); }
__device__ __forceinline__ float logsigmoid_(float x) { return x >= 0.f ? -log1pf(__expf(-x)) : x - log1pf(__expf(x)); }
__device__ __forceinline__ bf16x8 as_bf16x8(u32x4 w) { return __builtin_bit_cast(bf16x8, w); }
typedef short v4i16_t __attribute__((ext_vector_type(4)));
__device__ __forceinline__ u32x2 lds_tr(const LAS unsigned char* p) { return __builtin_bit_cast(u32x2, __builtin_amdgcn_ds_read_tr16_b64_v4i16((LAS v4i16_t*)p)); }
#define MFMA16(a, b, c) __builtin_amdgcn_mfma_f32_16x16x32_bf16((a), (b), (c), 0, 0, 0)
#define LDS_WAIT() asm volatile("s_waitcnt lgkmcnt(0)" ::: "memory")
#define VM_WAIT() asm volatile("s_waitcnt vmcnt(0)" ::: "memory")

#ifndef EPI_REP
#define EPI_REP 1
#endif
__device__ __forceinline__ void conv_fixup(const float* eraw, const float* ecv, const float* cw, unsigned short* act, unsigned* cnt, int tid, int G);
namespace pg8 {
constexpr int BM = 256, BK = 64, HALF = 128, HTB = HALF * BK * 2, STAGE_BYTES = 8 * HTB, NXCD = 8, WGM = 8;
__host__ __device__ __forceinline__ int lds_byte(int r, int c) { const int st = (r >> 4) * 2 + (c >> 5), rr = r & 15, cc = c & 31, ob = rr * 64 + cc * 2; return st * 1024 + (ob ^ (((ob >> 9) & 1) << 5)); }
__host__ __device__ __forceinline__ void stage_rc(int b, int& R, int& C) { const int st = b / 1024, sb = b % 1024, swz = sb ^ (((sb >> 9) & 1) << 5); R = (st >> 1) * 16 + swz / 64; C = (st & 1) * 32 + (swz % 64) / 2; }
__host__ __device__ __forceinline__ int perm32(int rho) { const int n = rho >> 4, i = rho & 15; return 8 * (i >> 2) + 4 * n + (i & 3); }
struct Unit { int pm, pn, kt0, nt; };
struct Gemm { const bf16_t* A; const bf16_t* Bt; int M, N, K; };
struct StaticOrder {
    static constexpr bool SPLITK = false;
    int nM, nN, nwg, G, c;
    __host__ __device__ void init(int M, int N, int G_, int c_) { nM = M / BM; nN = N / BM; nwg = nM * nN; G = G_; c = c_; }
    __host__ __device__ bool next(int i, Unit& u) const {
        const long L = (long)i * G + c; if (L >= nwg) return false;
        int wgid = (int)L; { const int q = nwg / NXCD, r = nwg % NXCD, xcd = wgid % NXCD, off = wgid / NXCD; wgid = (xcd < r ? xcd * (q + 1) : r * (q + 1) + (xcd - r) * q) + off; }
        const int nig = WGM * nN, gid = wgid / nig, fm = gid * WGM, gsz = (nM - fm) < WGM ? (nM - fm) : WGM;
        u.pm = fm + ((wgid % nig) % gsz); u.pn = (wgid % nig) / gsz; return true;
    }
    __device__ __forceinline__ void a_ready(const Unit&) const {}
    __device__ __forceinline__ void first_loads_issued() const {}
    __device__ __forceinline__ void done(const Unit&) const {}
};

struct SplitOrder {
    static constexpr bool SPLITK = true;
    int G, c, ntk; unsigned* fix; mutable int seen; const float* fx_eraw; const float* fx_ecv; const float* fx_cw; unsigned short* fx_act;
    __host__ __device__ void init(int K, int G_, int c_, unsigned* fix_) { G = G_; c = c_; ntk = K / BK; fix = fix_; seen = 0; }
    __device__ __forceinline__ void first_loads_issued() const { conv_fixup(fx_eraw, fx_ecv, fx_cw, fx_act, fix, (int)threadIdx.x, G); }
    __host__ __device__ bool next(int i, Unit& u) const {
        const int L = i * G + c; if (L >= 512) return false;
        int v = L & 255; v = (v & 7) * 32 + (v >> 3);
        const bool lat = L >= 256; const int q4 = ntk >> 2;
        u.pm = lat ? 32 + (v & 7) : (v & 7) + 8 * (v >> 6); u.pn = (v >> 3) & 7; u.nt = lat ? q4 : ntk; u.kt0 = lat ? (v >> 6) * q4 : 0;
        return true;
    }
    __device__ __forceinline__ void a_ready(const Unit& u) const {
        if (u.pm >= 32 && !seen) { seen = 1; unsigned sp = 0;
            while (__hip_atomic_load(fix, __ATOMIC_RELAXED, __HIP_MEMORY_SCOPE_AGENT) < (unsigned)G) { __builtin_amdgcn_s_sleep(2); if (++sp > (1u << 22)) break; }
            asm volatile("" ::: "memory"); }
    }
    __device__ __forceinline__ void done(const Unit&) const {}
};
struct EpiStore {
    static constexpr bool PERM = true, AFTER_DRAIN = false, REPEATABLE = false, HAS_PREFETCH = false;
    bf16_t* O; int ldc; float* gates; const float* mlb; int gates_pn;
    int gelu_pn; int ss_pn; float* rowss;
    __device__ __forceinline__ void operator()(const f32x4 (&acc)[2][2][4][2], const Unit& u, int wr, int wc, int fr, int fq) const {
        const int row0 = u.pm * BM + wr * 64 + 4 * fr; const int colt = u.pn * BM;
        if (u.pn >= gelu_pn) {
            const int col0 = colt + wc * 32 + 8 * fq; const bool do_ss = u.pn >= ss_pn;
#pragma unroll
            for (int ai = 0; ai < 2; ++ai)
#pragma unroll
                for (int m = 0; m < 4; ++m) { bf16_t* rowp = O + (size_t)(row0 + ai * HALF + m) * ldc + col0; float ss = 0.f;
#pragma unroll
                    for (int bj = 0; bj < 2; ++bj) { float gv[8];
#pragma unroll
                        for (int j = 0; j < 4; ++j) { gv[j] = gelu_tanh(acc[ai][bj][m][0][j]); gv[4 + j] = gelu_tanh(acc[ai][bj][m][1][j]); }
#pragma unroll
                        for (int j = 0; j < 8; ++j) ss += gv[j] * gv[j];
                        *(u32x4*)(rowp + bj * HALF) = pack8(gv); }
                    if (do_ss) { ss += __shfl_xor(ss, 16); ss += __shfl_xor(ss, 32); if (fq == 0) atomicAdd(rowss + row0 + ai * HALF + m, ss); } }
            return;
        }
        if (gates != nullptr && u.pn == gates_pn) {
            if (wc == 0) {
                const f32x4 b0 = *(const f32x4*)(mlb + 8 * fq), b1 = *(const f32x4*)(mlb + 8 * fq + 4);
#pragma unroll
                for (int ai = 0; ai < 2; ++ai)
#pragma unroll
                    for (int m = 0; m < 4; ++m) { float* rp = gates + (size_t)(row0 + ai * HALF + m) * 32 + 8 * fq;
                        *(f32x4*)rp = acc[ai][0][m][0] + b0; *(f32x4*)(rp + 4) = acc[ai][0][m][1] + b1; }
            }
            return;
        }
        const int col0 = colt + wc * 32 + 8 * fq;
#pragma unroll
        for (int ai = 0; ai < 2; ++ai)
#pragma unroll
            for (int m = 0; m < 4; ++m) { bf16_t* rowp = O + (size_t)(row0 + ai * HALF + m) * ldc + col0;
#pragma unroll
                for (int bj = 0; bj < 2; ++bj) { const f32x4 v0 = acc[ai][bj][m][0], v1 = acc[ai][bj][m][1];
                    u32x4 w; w.x = cvt_pk_bf16(v0[0], v0[1]); w.y = cvt_pk_bf16(v0[2], v0[3]); w.z = cvt_pk_bf16(v1[0], v1[1]); w.w = cvt_pk_bf16(v1[2], v1[3]);
                    *(u32x4*)(rowp + bj * HALF) = w; } }
    }
};
__device__ __forceinline__ float dpp_f(float oldv, float src, const int ctrl_sel) {
    const int o = __builtin_bit_cast(int, oldv), v = __builtin_bit_cast(int, src); int r;
    if (ctrl_sel == 0) r = __builtin_amdgcn_update_dpp(o, v, 0x111, 0xf, 0xf, false);
    else if (ctrl_sel == 1) r = __builtin_amdgcn_update_dpp(o, v, 0x101, 0xf, 0xf, false);
    else if (ctrl_sel == 2) r = __builtin_amdgcn_update_dpp(o, v, 0x10f, 0xf, 0xf, false);
    else r = __builtin_amdgcn_update_dpp(o, v, 0x11f, 0xf, 0xf, false);
    return __builtin_bit_cast(float, r);
}
__device__ __forceinline__ float dpp_z(float src, const int ctrl_sel) {
    const int v = __builtin_bit_cast(int, src); int r;
    if (ctrl_sel == 0) r = __builtin_amdgcn_update_dpp(0, v, 0x111, 0xf, 0xf, true);
    else if (ctrl_sel == 1) r = __builtin_amdgcn_update_dpp(0, v, 0x101, 0xf, 0xf, true);
    else if (ctrl_sel == 2) r = __builtin_amdgcn_update_dpp(0, v, 0x10f, 0xf, 0xf, true);
    else r = __builtin_amdgcn_update_dpp(0, v, 0x11f, 0xf, 0xf, true);
    return __builtin_bit_cast(float, r);
}
__device__ __forceinline__ void fmac_dpp(float& v, float src, float w, const int sel) {
    if (sel == 0) asm("v_fmac_f32_dpp %0, %1, %2 row_shr:1 row_mask:0xf bank_mask:0xf bound_ctrl:1" : "+v"(v) : "v"(src), "v"(w));
    else if (sel == 1) asm("v_fmac_f32_dpp %0, %1, %2 row_shl:1 row_mask:0xf bank_mask:0xf bound_ctrl:1" : "+v"(v) : "v"(src), "v"(w));
    else if (sel == 2) asm("v_fmac_f32_dpp %0, %1, %2 row_shl:15 row_mask:0xf bank_mask:0xf bound_ctrl:1" : "+v"(v) : "v"(src), "v"(w));
    else asm("v_fmac_f32_dpp %0, %1, %2 row_shr:15 row_mask:0xf bank_mask:0xf bound_ctrl:1" : "+v"(v) : "v"(src), "v"(w));
}
struct EpiConv {
    static constexpr bool PERM = true, AFTER_DRAIN = false, REPEATABLE = false, HAS_PREFETCH = true;
    float* eraw; float* ecv; bf16_t* act; const float* cw; const float* cb; LAS float* edge;
    const float* rowss; const float* bias;
    LAS float* cst;
    __device__ __forceinline__ void prefetch(const Unit& u, int par) const {
        const int w = __builtin_amdgcn_readfirstlane((int)(threadIdx.x >> 6)), l = threadIdx.x & 63;
        if (w < 6) {
            const int cond = u.pm < 32 ? 0 : 1 + ((u.pm - 32) >> 2);
            const int co = (l >> 5) * D_FF + u.pn * 128 + (l & 31) * 4;
            const float* src = (w < 3) ? cw + (size_t)w * D_FF2 + co : (w == 3) ? cb + co : (w == 4) ? bias + (size_t)cond * D_FF2 + co : rowss + u.pm * 256 + l * 4;
            __builtin_amdgcn_global_load_lds((const unsigned*)src, (LAS unsigned*)(cst + par * 1536 + w * 256), 16, 0, 0);
        }
    }
    __device__ __forceinline__ void operator()(const f32x4 (&acc_in)[2][2][4][2], const Unit& u, int wr, int wc, int fr, int fq, int par) const {
        const int row0 = u.pm * BM + wr * 64 + 4 * fr;
        f32x4 (&acc)[2][2][4][2] = const_cast<f32x4 (&)[2][2][4][2]>(acc_in);
        const LAS float* cs = cst + par * 1536;
        int c0 = wc * 32 + 8 * fq;
        asm volatile("" : "+v"(c0));
        {
            f32x4 bb[2][2];
#pragma unroll
            for (int bj = 0; bj < 2; ++bj)
#pragma unroll
                for (int n = 0; n < 2; ++n) bb[bj][n] = *(const LAS f32x4*)(cs + 4 * 256 + bj * 128 + c0 + 4 * n);
            const LAS float* rsp = cs + 5 * 256 + wr * 64 + (c0 * 0) + 4 * fr;
#pragma unroll
            for (int ai = 0; ai < 2; ++ai)
#pragma unroll
                for (int m = 0; m < 4; ++m) { const float rs = rsqrtf(rsp[ai * HALF + m] * (1.f / D_MODEL) + EPS);
#pragma unroll
                    for (int bj = 0; bj < 2; ++bj)
#pragma unroll
                        for (int n = 0; n < 2; ++n) acc[ai][bj][m][n] = acc[ai][bj][m][n] * rs + bb[bj][n]; }
        }
        const bool lat = u.pm >= 32;
        const size_t eo_g = ((size_t)((u.pm - 32) * 2 + wr) * 44 + u.pn) * 256 + c0;
        if (fr == 0) {
#pragma unroll
            for (int ai = 0; ai < 2; ++ai)
#pragma unroll
                for (int bj = 0; bj < 2; ++bj)
#pragma unroll
                    for (int n = 0; n < 2; ++n) *(LAS f32x4*)(edge + (((ai * 2 + wr) * 2 + 0) * 256 + bj * 128 + c0 + 4 * n)) = acc[ai][bj][0][n];
            if (lat && wr == 0) {
#pragma unroll
                for (int bj = 0; bj < 2; ++bj)
#pragma unroll
                    for (int n = 0; n < 2; ++n) *(f32x4*)(eraw + eo_g + bj * 128 + 4 * n) = acc[0][bj][0][n];
            }
        }
        if (fr == 15) {
#pragma unroll
            for (int ai = 0; ai < 2; ++ai)
#pragma unroll
                for (int bj = 0; bj < 2; ++bj)
#pragma unroll
                    for (int n = 0; n < 2; ++n) *(LAS f32x4*)(edge + (((ai * 2 + wr) * 2 + 1) * 256 + bj * 128 + c0 + 4 * n)) = acc[ai][bj][3][n];
            if (lat && wr == 1) {
#pragma unroll
                for (int bj = 0; bj < 2; ++bj)
#pragma unroll
                    for (int n = 0; n < 2; ++n) *(f32x4*)(eraw + eo_g + bj * 128 + 4 * n) = acc[1][bj][3][n];
            }
        }
        asm volatile("s_waitcnt lgkmcnt(0)" ::: "memory"); __builtin_amdgcn_s_barrier(); asm volatile("" ::: "memory");
        __builtin_amdgcn_sched_barrier(0);
        const int ncol = u.pn * 128 + c0;
        u32x2 held[2][4];
#pragma unroll
        for (int n = 0; n < 2; ++n) {
            f32x4 wg[3], wv[3];
#pragma unroll
            for (int t = 0; t < 3; ++t) { wg[t] = *(const LAS f32x4*)(cs + t * 256 + c0 + 4 * n); wv[t] = *(const LAS f32x4*)(cs + t * 256 + 128 + c0 + 4 * n); }
            const f32x4 bg = *(const LAS f32x4*)(cs + 3 * 256 + c0 + 4 * n), bv = *(const LAS f32x4*)(cs + 3 * 256 + 128 + c0 + 4 * n);
#pragma unroll
            for (int ai = 0; ai < 2; ++ai) {
#pragma unroll
                for (int m = 0; m < 4; ++m) {
                    f32x4 pe[2] = {(f32x4){0.f, 0.f, 0.f, 0.f}, (f32x4){0.f, 0.f, 0.f, 0.f}}, ne[2] = {(f32x4){0.f, 0.f, 0.f, 0.f}, (f32x4){0.f, 0.f, 0.f, 0.f}};
                    if (m == 0) {
#pragma unroll
                        for (int bj = 0; bj < 2; ++bj) { const int eo = bj * 128 + c0 + 4 * n;
                            if (wr == 1) pe[bj] = *(const LAS f32x4*)(edge + (((ai * 2 + 0) * 2 + 1) * 256 + eo));
                            else if (ai == 1) pe[bj] = *(const LAS f32x4*)(edge + (((0 * 2 + 1) * 2 + 1) * 256 + eo)); }
                    }
                    if (m == 3) {
#pragma unroll
                        for (int bj = 0; bj < 2; ++bj) { const int eo = bj * 128 + c0 + 4 * n;
                            if (wr == 0) ne[bj] = *(const LAS f32x4*)(edge + (((ai * 2 + 1) * 2 + 0) * 256 + eo));
                            else if (ai == 0) ne[bj] = *(const LAS f32x4*)(edge + (((1 * 2 + 0) * 2 + 0) * 256 + eo)); }
                    }
                    f32x4 cvg, cvv;
#pragma unroll
                    for (int bj = 0; bj < 2; ++bj) {
                        const f32x4 cur = acc[ai][bj][m][n]; const f32x4* w = bj ? wv : wg;
                        f32x4 v = w[1] * cur + (bj ? bv : bg);
                        if (m > 0) v = w[0] * acc[ai][bj][m > 0 ? m - 1 : 0][n] + v;
                        else {
#pragma unroll
                            for (int j = 0; j < 4; ++j) { float t_ = v[j]; fmac_dpp(t_, acc[ai][bj][3][n][j], w[0][j], 0); v[j] = t_; }
                            const f32x4 pz = (fr == 0) ? pe[bj] : (f32x4){0.f, 0.f, 0.f, 0.f}; v = w[0] * pz + v; }
                        if (m < 3) v = w[2] * acc[ai][bj][m < 3 ? m + 1 : 3][n] + v;
                        else {
#pragma unroll
                            for (int j = 0; j < 4; ++j) { float t_ = v[j]; fmac_dpp(t_, acc[ai][bj][0][n][j], w[2][j], 1); v[j] = t_; }
                            const f32x4 nz = (fr == 15) ? ne[bj] : (f32x4){0.f, 0.f, 0.f, 0.f}; v = w[2] * nz + v; }
                        if (bj) cvv = v; else cvg = v;
                    }
                    if ((ai == 0 && m == 0) || (ai == 1 && m == 3)) {
                        if (lat && wr == ai && fr == (ai ? 15 : 0)) { float* ep = ecv + eo_g + 4 * n; *(f32x4*)ep = cvg; *(f32x4*)(ep + 128) = cvv; }
                    }
                    f32x4 o;
                    { const f32x4 t = cvg * -1.4426950408889634f; f32x4 e;
#pragma unroll
                      for (int j = 0; j < 4; ++j) e[j] = __builtin_amdgcn_exp2f(t[j]);
                      e = e + 1.f;
#pragma unroll
                      for (int j = 0; j < 4; ++j) e[j] = __builtin_amdgcn_rcpf(e[j]);
                      o = (cvg * cvv) * e; }
                    u32x2 w2; w2.x = cvt_pk_bf16(o[0], o[1]); w2.y = cvt_pk_bf16(o[2], o[3]);
                    if (n == 0) held[ai][m] = w2;
                    else *(u32x4*)(act + (size_t)(row0 + ai * HALF + m) * D_FF + ncol) = (u32x4){held[ai][m].x, held[ai][m].y, w2.x, w2.y};
                }
            }
        }
    }
};
template <bool RB, bool OB, bool PF = false>
struct EpiRes {
    static constexpr bool PERM = true, AFTER_DRAIN = false, REPEATABLE = false, HAS_PREFETCH = false;
    const void* res0; const void* res1; void* outp; const float* gvec; bf16_t* part;
    bf16_t* hA; const float* gnorm; const float* nscale; float* rowss;
    __device__ __forceinline__ void operator()(const f32x4 (&acc)[2][2][4][2], const Unit& u, int wr, int wc, int fr, int fq) const {
        const int row0 = u.pm * BM + wr * 64 + 4 * fr; const int colt = u.pn * BM;
        if (part != nullptr && u.pm >= 32) {
            bf16_t* pb = part + ((size_t)(u.kt0 / u.nt) * NLAT + (row0 - NCTX)) * D_MODEL + colt + wc * 32 + 8 * fq;
#pragma unroll
            for (int ai = 0; ai < 2; ++ai)
#pragma unroll
                for (int m = 0; m < 4; ++m)
#pragma unroll
                    for (int bj = 0; bj < 2; ++bj) { const f32x4 v0 = acc[ai][bj][m][0], v1 = acc[ai][bj][m][1];
                        u32x4 w; w.x = cvt_pk_bf16(v0[0], v0[1]); w.y = cvt_pk_bf16(v0[2], v0[3]); w.z = cvt_pk_bf16(v1[0], v1[1]); w.w = cvt_pk_bf16(v1[2], v1[3]);
                        *(u32x4*)(pb + (size_t)(ai * HALF + m) * D_MODEL + bj * HALF) = w; }
            return;
        }
        const int cond = u.pm < 32 ? 0 : 1 + ((u.pm - 32) >> 2);
        const int col0 = colt + wc * 32 + 8 * fq;
        const float* gv = gvec + (size_t)cond * 12288 + col0;
        f32x4 g[2][2];
#pragma unroll
        for (int bj = 0; bj < 2; ++bj)
#pragma unroll
            for (int n = 0; n < 2; ++n) g[bj][n] = *(const f32x4*)(gv + bj * HALF + 4 * n);
        f32x4 gn[2][2];
        if (hA != nullptr) {
#pragma unroll
            for (int bj = 0; bj < 2; ++bj)
#pragma unroll
                for (int n = 0; n < 2; ++n) gn[bj][n] = *(const f32x4*)(gnorm + col0 + bj * HALF + 4 * n) * (*(const f32x4*)(nscale + (size_t)cond * 12288 + col0 + bj * HALF + 4 * n) + 1.f);
        }
        const size_t rrow = (u.pm < 32) ? (size_t)row0 : (size_t)(row0 - NCTX);
        const char* rbase = (const char*)(u.pm < 32 ? res0 : res1) + (rrow * D_MODEL + col0) * (RB ? 2 : 4);
        char* obase = (char*)outp + ((size_t)row0 * D_MODEL + col0) * (OB ? 2 : 4);
        u32x4 rrb[2][2][2][2]; f32x4 rrf[2][2][2][2];
        if (RB && PF) {
#pragma unroll
            for (int ai = 0; ai < 2; ++ai)
#pragma unroll
                for (int mh = 0; mh < 2; ++mh)
#pragma unroll
                    for (int m2 = 0; m2 < 2; ++m2)
#pragma unroll
                        for (int bj = 0; bj < 2; ++bj) rrb[ai][mh][m2][bj] = *(const u32x4*)(rbase + ((size_t)(ai * HALF + (2 * mh + m2)) * D_MODEL + bj * HALF) * 2);
        }
#pragma unroll
        for (int ai = 0; ai < 2; ++ai) {
#pragma unroll
          for (int mh = 0; mh < 2; ++mh) {
            if (!(RB && PF)) {
#pragma unroll
                for (int m2 = 0; m2 < 2; ++m2)
#pragma unroll
                    for (int bj = 0; bj < 2; ++bj) { const size_t eo = (size_t)(ai * HALF + (2 * mh + m2)) * D_MODEL + bj * HALF;
                        if (RB) rrb[ai][mh][m2][bj] = *(const u32x4*)(rbase + eo * 2);
                        else { rrf[mh][m2][bj][0] = *(const f32x4*)(rbase + eo * 4); rrf[mh][m2][bj][1] = *(const f32x4*)(rbase + eo * 4 + 16); } }
            }
#pragma unroll
            for (int m2 = 0; m2 < 2; ++m2) { const int m = 2 * mh + m2; float ss = 0.f;
#pragma unroll
                for (int bj = 0; bj < 2; ++bj) { const size_t eo = (size_t)(ai * HALF + m) * D_MODEL + bj * HALF;
                    f32x4 r0, r1;
                    if (RB) { float f8[8]; unpack8(rrb[ai][mh][m2][bj], f8); r0 = (f32x4){f8[0], f8[1], f8[2], f8[3]}; r1 = (f32x4){f8[4], f8[5], f8[6], f8[7]}; }
                    else { r0 = rrf[mh][m2][bj][0]; r1 = rrf[mh][m2][bj][1]; }
                    const f32x4 v0 = r0 + g[bj][0] * acc[ai][bj][m][0], v1 = r1 + g[bj][1] * acc[ai][bj][m][1];
                    if (OB) { u32x4 w; w.x = cvt_pk_bf16(v0[0], v0[1]); w.y = cvt_pk_bf16(v0[2], v0[3]); w.z = cvt_pk_bf16(v1[0], v1[1]); w.w = cvt_pk_bf16(v1[2], v1[3]); *(u32x4*)(obase + eo * 2) = w; }
                    else { *(f32x4*)(obase + eo * 4) = v0; *(f32x4*)(obase + eo * 4 + 16) = v1; }
                    if (hA != nullptr) { const f32x4 h0 = v0 * gn[bj][0], h1 = v1 * gn[bj][1];
                        u32x4 w; w.x = cvt_pk_bf16(h0[0], h0[1]); w.y = cvt_pk_bf16(h0[2], h0[3]); w.z = cvt_pk_bf16(h1[0], h1[1]); w.w = cvt_pk_bf16(h1[2], h1[3]);
                        *(u32x4*)(hA + (size_t)(row0 + ai * HALF + m) * D_MODEL + col0 + bj * HALF) = w;
                        ss += (v0[0] * v0[0] + v0[1] * v0[1]) + (v0[2] * v0[2] + v0[3] * v0[3]) + (v1[0] * v1[0] + v1[1] * v1[1]) + (v1[2] * v1[2] + v1[3] * v1[3]); } }
                if (hA != nullptr) { ss += __shfl_xor(ss, 16); ss += __shfl_xor(ss, 32); if (fq == 0) atomicAdd(rowss + row0 + ai * HALF + m, ss); } }
            asm volatile("" ::: "memory");
          }
        }
    }
};

template <class Epi, class Sched, bool ALIGN_EPI = false, bool SP2 = false>
__device__ __forceinline__ void gemm_phase(LAS unsigned char* lds, const Gemm g, const Sched& S, const Epi& E) {
    const int tid = threadIdx.x, wid = __builtin_amdgcn_readfirstlane(tid >> 6), lane = tid & 63, wr = wid >> 2, wc = wid & 3, fr = lane & 15, fq = lane >> 4;
    const int K = g.K, nt = K / BK;
    unsigned voffA[2], voffB[2];
#pragma unroll
    for (int i = 0; i < 2; ++i) { int R, C; stage_rc(tid * 16 + i * 8192, R, C); const int Rb = Epi::PERM ? ((R & ~31) + perm32(R & 31)) : R;
        const int Ra = Epi::PERM ? ((R & ~63) + 4 * (R & 15) + ((R >> 4) & 3)) : R;
        voffA[i] = (unsigned)(Ra * K + C) * 2u; voffB[i] = (unsigned)(Rb * K + C) * 2u; }
    const size_t kstep = (size_t)(BK * 2);
    const size_t hstep = (size_t)HALF * K * 2;
    const size_t tstep = 2 * hstep;
    const unsigned ldsw = (unsigned)wid * 1024u;
    const int aoff = lds_byte(wr * 64 + fr, fq * 8), boff = lds_byte(wc * 32 + fr, fq * 8);
#define PG8_SA(b, h) (((b) * 2 + (h)) * HTB)
#define PG8_SB(b, h) ((4 + (b) * 2 + (h)) * HTB)
#define PG8_STAGE(bufoff, gbase, voff) do { _Pragma("unroll") for (int _i = 0; _i < 2; ++_i) \
        __builtin_amdgcn_global_load_lds((const unsigned*)((const char*)(gbase) + (voff)[_i]), (LAS unsigned*)(lds + (bufoff) + ldsw + _i * 8192), 16, 0, 0); } while (0)
#define PG8_LDA(dst, b, h) do { _Pragma("unroll") for (int m = 0; m < 4; ++m) _Pragma("unroll") for (int k = 0; k < 2; ++k) dst[m][k] = *(const LAS bf16x8*)(lds + PG8_SA(b, h) + aoff + m * 2048 + k * 1024); } while (0)
#define PG8_LDB(dst, b, h) do { _Pragma("unroll") for (int n = 0; n < 2; ++n) _Pragma("unroll") for (int k = 0; k < 2; ++k) dst[n][k] = *(const LAS bf16x8*)(lds + PG8_SB(b, h) + boff + n * 2048 + k * 1024); } while (0)
#define PG8_MMA(ai, bj, At, Bt) do { __builtin_amdgcn_s_setprio(1); _Pragma("unroll") for (int m = 0; m < 4; ++m) _Pragma("unroll") for (int n = 0; n < 2; ++n) _Pragma("unroll") for (int k = 0; k < 2; ++k) \
        acc[ai][bj][m][n] = __builtin_amdgcn_mfma_f32_16x16x32_bf16(Bt[n][k], At[m][k], acc[ai][bj][m][n], 0, 0, 0); __builtin_amdgcn_s_setprio(0); } while (0)
#define PG8_WAIT_V(n) asm volatile("s_waitcnt vmcnt(" #n ")" ::: "memory")
#define PG8_WAIT_L(n) asm volatile("s_waitcnt lgkmcnt(" #n ")" ::: "memory")
#define PG8_BAR __builtin_amdgcn_s_barrier()
#define PG8_SCHED __builtin_amdgcn_sched_barrier(0)
    Unit cur, nxt; int ui = 0;
    if (!S.next(0, cur)) return;
    f32x4 acc[2][2][4][2];
#pragma unroll
    for (int a = 0; a < 2; ++a)
#pragma unroll
        for (int b = 0; b < 2; ++b)
#pragma unroll
            for (int m = 0; m < 4; ++m)
#pragma unroll
                for (int n = 0; n < 2; ++n) acc[a][b][m][n] = (f32x4){0.f, 0.f, 0.f, 0.f};
    bf16x8 At[4][2], B0[2][2], B1[2][2];
    int cnt = nt;
    const char* cA = (const char*)g.A + (size_t)cur.pm * tstep; const char* cB = (const char*)g.Bt + (size_t)cur.pn * tstep;
    if constexpr (Sched::SPLITK) { cnt = cur.nt; cA += (size_t)cur.kt0 * kstep; cB += (size_t)cur.kt0 * kstep; }
    S.a_ready(cur);
    if constexpr (Epi::HAS_PREFETCH) E.prefetch(cur, 0);
    if constexpr (SP2) {
        PG8_STAGE(PG8_SB(0, 0), cB, voffB); PG8_STAGE(PG8_SB(0, 1), cB + hstep, voffB); PG8_STAGE(PG8_SA(0, 0), cA, voffA); PG8_STAGE(PG8_SA(0, 1), cA + hstep, voffA);
        S.first_loads_issued();
        if (wr == 1) PG8_BAR;
        PG8_WAIT_V(2); PG8_BAR;
        PG8_STAGE(PG8_SB(1, 0), cB + kstep, voffB); PG8_STAGE(PG8_SA(1, 0), cA + kstep, voffA); PG8_STAGE(PG8_SB(1, 1), cB + hstep + kstep, voffB);
        PG8_WAIT_V(6); PG8_BAR;
    } else {
        PG8_STAGE(PG8_SB(0, 0), cB, voffB); PG8_STAGE(PG8_SA(0, 0), cA, voffA); PG8_STAGE(PG8_SB(0, 1), cB + hstep, voffB); PG8_STAGE(PG8_SA(0, 1), cA + hstep, voffA);
        if (wr == 1) PG8_BAR;
        PG8_WAIT_V(4); PG8_BAR;
        PG8_STAGE(PG8_SB(1, 0), cB + kstep, voffB); PG8_STAGE(PG8_SA(1, 0), cA + kstep, voffA); PG8_STAGE(PG8_SB(1, 1), cB + hstep + kstep, voffB);
        PG8_WAIT_V(6); PG8_BAR;
    }
    for (;;) {
        const bool has_next = S.next(ui + 1, nxt);
        const char* nA = has_next ? (const char*)g.A + (size_t)nxt.pm * tstep : cA; const char* nB = has_next ? (const char*)g.Bt + (size_t)nxt.pn * tstep : cB;
        if constexpr (Sched::SPLITK) { if (has_next) { nA += (size_t)nxt.kt0 * kstep; nB += (size_t)nxt.kt0 * kstep; } }
        for (int t = 0; t < cnt; t += 2) {
            const bool last = (t == cnt - 2);
            const char* a1 = cA + (size_t)(t + 1) * kstep;
            const char* a2 = last ? nA : cA + (size_t)(t + 2) * kstep; const char* b2 = last ? nB : cB + (size_t)(t + 2) * kstep;
            const char* a3 = a2 + kstep; const char* b3 = b2 + kstep;
            if (last && has_next) S.a_ready(nxt);
            if constexpr (SP2) {
            PG8_LDB(B0, 0, 0); PG8_LDB(B1, 0, 1); PG8_SCHED; PG8_LDA(At, 0, 0); PG8_STAGE(PG8_SA(1, 1), a1 + hstep, voffA);
            PG8_WAIT_V(8); PG8_WAIT_L(0); PG8_BAR; PG8_MMA(0, 0, At, B0); PG8_MMA(0, 1, At, B1); PG8_BAR; PG8_SCHED;
            PG8_LDA(At, 0, 1); PG8_STAGE(PG8_SB(0, 0), b2, voffB); PG8_STAGE(PG8_SB(0, 1), b2 + hstep, voffB); PG8_STAGE(PG8_SA(0, 0), a2, voffA);
            PG8_WAIT_V(8); PG8_WAIT_L(0); PG8_BAR; PG8_MMA(1, 0, At, B0); PG8_MMA(1, 1, At, B1); PG8_BAR; PG8_SCHED;
            PG8_LDB(B0, 1, 0); PG8_LDB(B1, 1, 1); PG8_SCHED; PG8_LDA(At, 1, 0); PG8_STAGE(PG8_SA(0, 1), a2 + hstep, voffA);
            PG8_WAIT_V(8); PG8_WAIT_L(0); PG8_BAR; PG8_MMA(0, 0, At, B0); PG8_MMA(0, 1, At, B1); PG8_BAR; PG8_SCHED;
            PG8_LDA(At, 1, 1); PG8_STAGE(PG8_SB(1, 0), b3, voffB); PG8_STAGE(PG8_SB(1, 1), b3 + hstep, voffB); PG8_STAGE(PG8_SA(1, 0), a3, voffA);
            PG8_WAIT_V(8); PG8_WAIT_L(0); PG8_BAR; PG8_MMA(1, 0, At, B0); PG8_MMA(1, 1, At, B1); PG8_BAR; PG8_SCHED;
            } else {
            PG8_LDB(B0, 0, 0); PG8_SCHED; PG8_LDA(At, 0, 0); PG8_STAGE(PG8_SA(1, 1), a1 + hstep, voffA);
            PG8_WAIT_L(8); PG8_BAR; PG8_WAIT_L(0); PG8_MMA(0, 0, At, B0); PG8_BAR; PG8_SCHED;
            PG8_LDB(B1, 0, 1); PG8_STAGE(PG8_SB(0, 0), b2, voffB);
            PG8_BAR; PG8_WAIT_L(0); PG8_MMA(0, 1, At, B1); PG8_BAR;
            PG8_LDA(At, 0, 1); PG8_STAGE(PG8_SA(0, 0), a2, voffA);
            PG8_BAR; PG8_WAIT_L(0); PG8_MMA(1, 0, At, B0); PG8_BAR; PG8_SCHED;
            PG8_STAGE(PG8_SB(0, 1), b2 + hstep, voffB);
            PG8_WAIT_V(6); PG8_BAR; PG8_MMA(1, 1, At, B1); PG8_BAR;
            PG8_LDB(B0, 1, 0); PG8_SCHED; PG8_LDA(At, 1, 0); PG8_STAGE(PG8_SA(0, 1), a2 + hstep, voffA);
            PG8_WAIT_L(8); PG8_BAR; PG8_WAIT_L(0); PG8_MMA(0, 0, At, B0); PG8_BAR; PG8_SCHED;
            PG8_LDB(B1, 1, 1); PG8_STAGE(PG8_SB(1, 0), b3, voffB);
            PG8_BAR; PG8_WAIT_L(0); PG8_MMA(0, 1, At, B1); PG8_BAR;
            PG8_LDA(At, 1, 1); PG8_STAGE(PG8_SA(1, 0), a3, voffA);
            PG8_BAR; PG8_WAIT_L(0); PG8_MMA(1, 0, At, B0); PG8_BAR; PG8_SCHED;
            PG8_STAGE(PG8_SB(1, 1), b3 + hstep, voffB);
            PG8_WAIT_V(6); PG8_BAR; PG8_MMA(1, 1, At, B1); PG8_BAR;
            }
        }
        if constexpr (ALIGN_EPI) { if (wr == 0) PG8_BAR; }
        if constexpr (!Epi::AFTER_DRAIN) { if constexpr (Epi::HAS_PREFETCH) E(acc, cur, wr, wc, fr, fq, ui & 1); else E(acc, cur, wr, wc, fr, fq); S.done(cur); }
        if (!has_next) break;
#pragma unroll
        for (int a = 0; a < 2; ++a)
#pragma unroll
            for (int b = 0; b < 2; ++b)
#pragma unroll
                for (int m = 0; m < 4; ++m)
#pragma unroll
                    for (int n = 0; n < 2; ++n) acc[a][b][m][n] = (f32x4){0.f, 0.f, 0.f, 0.f};
        cur = nxt; cA = nA; cB = nB; ++ui;
        if constexpr (Epi::HAS_PREFETCH) E.prefetch(cur, ui & 1);
        if constexpr (Sched::SPLITK) cnt = cur.nt;
        if constexpr (ALIGN_EPI) { if (wr == 1) PG8_BAR; }
    }
    PG8_WAIT_V(0);
    if constexpr (!ALIGN_EPI) { if (wr == 0) PG8_BAR; }
    PG8_BAR;
#undef PG8_SA
#undef PG8_SB
#undef PG8_STAGE
#undef PG8_LDA
#undef PG8_LDB
#undef PG8_MMA
#undef PG8_WAIT_V
#undef PG8_WAIT_L
#undef PG8_BAR
#undef PG8_SCHED
}
}

#define XB_TMO      128
#define XB_XCNT(j)  (256  + 64 * (j))
#define XB_XSUB(j)  (1280 + 64 * (j))
#define XB_XGEN(j)  (2304 + 64 * (j))
#define XB_TOP      3328
#define XB_TOPGEN   3392
#define XCD_BAR_WORDS 3456
#define XB_SPIN_CAP (1u << 18)
__device__ __forceinline__ unsigned xb_ld(unsigned* p)              { return __hip_atomic_load(p, __ATOMIC_RELAXED, __HIP_MEMORY_SCOPE_AGENT); }
__device__ __forceinline__ unsigned xb_add(unsigned* p, unsigned v) { return __hip_atomic_fetch_add(p, v, __ATOMIC_RELAXED, __HIP_MEMORY_SCOPE_AGENT); }
__device__ __forceinline__ unsigned xb_xcc_id() { return (unsigned)__builtin_amdgcn_s_getreg((3 << 11) | 20) & 0xFu; }
#define XB_SPIN(cond, bar) do { unsigned _sp = 0; while (cond) { __builtin_amdgcn_s_sleep(1); \
    if ((++_sp & 255u) == 0u) { if (xb_ld(&(bar)[XB_TMO])) break; if (_sp > XB_SPIN_CAP) { atomicAdd(&(bar)[XB_TMO], 1u); break; } } } } while (0)
struct XcdBarrier { unsigned* bar; unsigned x; volatile LAS unsigned* st; };
__device__ __forceinline__ XcdBarrier xcd_barrier_post(unsigned* bar, volatile LAS unsigned* st) {
    XcdBarrier b; b.bar = bar; b.x = xb_xcc_id(); b.st = st;
    if (threadIdx.x == 0) (void)xb_add(&bar[XB_XCNT(b.x)], 1u);
    return b;
}
__device__ __forceinline__ void xcd_barrier_complete(unsigned* bar, unsigned x, unsigned& nloc, unsigned& nx) {
    const unsigned G = gridDim.x * gridDim.y * gridDim.z;
    unsigned sum, cnt, mine, sp = 0u;
    for (;;) {
        sum = 0u; cnt = 0u; mine = 0u;
#pragma unroll
        for (unsigned j = 0; j < 16; ++j) { const unsigned c = xb_ld(&bar[XB_XCNT(j)]); sum += c; cnt += (c > 0u) ? 1u : 0u; mine = (j == x) ? c : mine; }
        if (sum == G) break;
        __builtin_amdgcn_s_sleep(1);
        if ((++sp & 255u) == 0u) { if (xb_ld(&bar[XB_TMO])) break; if (sp > XB_SPIN_CAP) { atomicAdd(&bar[XB_TMO], 1u); break; } }
    }
    nloc = mine > 0u ? mine : 1u; nx = cnt > 0u ? cnt : 1u;
}
__device__ __forceinline__ void xcd_barrier(const XcdBarrier& b) {
    asm volatile("s_waitcnt vmcnt(0)" ::: "memory");
    __syncthreads();
    if (threadIdx.x == 0) {
        unsigned* bar = b.bar;
        __builtin_amdgcn_s_waitcnt(0);
        unsigned nloc = b.st[0], nx = b.st[1];
        if (nloc == 0u) { xcd_barrier_complete(bar, b.x, nloc, nx); b.st[0] = nloc; b.st[1] = nx; }
        const unsigned old = xb_add(&bar[XB_XSUB(b.x)], 1u);
        __builtin_amdgcn_fence(__ATOMIC_ACQUIRE, "agent");
        const unsigned gen = old / nloc;
        if (old + 1u == (gen + 1u) * nloc) {
            __builtin_amdgcn_fence(__ATOMIC_RELEASE, "agent");
            asm volatile("s_waitcnt vmcnt(0)" ::: "memory");
            (void)xb_add(&bar[XB_TOP], 1u);
        }
        XB_SPIN(xb_ld(&bar[XB_TOP]) < (gen + 1u) * nx, bar);
        asm volatile("s_waitcnt vmcnt(0)" ::: "memory");
    }
    __syncthreads();
}

struct Args { const float* in[34]; float* out; unsigned char* ws; int ph_lo, ph_hi; };
enum { I_XP = 0, I_XS, I_CNAK, I_CNAV, I_SMC, I_SMN, I_SMM, I_CDK, I_CDV, I_C, I_CCTX, I_WMOD, I_BMOD, I_GMIX, I_GFFN, I_WOUT, I_WINE, I_NAGQ, I_NAGK, I_RPB, I_MLB, I_MLG,
       I_WINO, I_DGQ, I_DGK, I_DLAM, I_DGOUT, I_SGG, I_SGW, I_SGB, I_WUP, I_CONVW, I_CONVB, I_WDN };

__device__ __forceinline__ void p0_transpose_item(const float* W, int K, int N, bf16_t* WT, LAS float* scr, int item, int lane, bool ffn_up = false, const float* bias_sf = nullptr, float* bias_out = nullptr) {
    const int nblk = N / 32, kb = item / nblk, nb = item % nblk, k0 = 64 * kb, n0 = 32 * nb;
    const int d0 = ffn_up ? (n0 < D_FF ? 256 * (n0 >> 7) + (n0 & 127) : 256 * ((n0 - D_FF) >> 7) + 128 + ((n0 - D_FF) & 127)) : n0;
    { f32x4 t[8];
#pragma unroll
      for (int i = 0; i < 8; ++i) t[i] = *(const f32x4*)(W + (size_t)(k0 + 8 * i + (lane >> 3)) * N + n0 + 4 * (lane & 7));
#pragma unroll
      for (int i = 0; i < 8; ++i) { LAS float* d = scr + (8 * i + (lane >> 3)) * 33 + 4 * (lane & 7); d[0] = t[i].x; d[1] = t[i].y; d[2] = t[i].z; d[3] = t[i].w; } }
    LDS_WAIT(); asm volatile("" ::: "memory");
    if (ffn_up) {
        float sb[3] = {0.f, 0.f, 0.f};
        const float* sf = bias_sf + k0 + 32 * (lane >> 5);
#pragma unroll 8
        for (int kk = 0; kk < 32; ++kk) { const float w = scr[(32 * (lane >> 5) + kk) * 33 + (lane & 31)];
#pragma unroll
            for (int r = 0; r < 3; ++r) sb[r] += sf[(size_t)r * 12288 + kk] * w; }
#pragma unroll
        for (int r = 0; r < 3; ++r) { sb[r] += __shfl_xor(sb[r], 32); if (lane < 32) atomicAdd(bias_out + (size_t)r * D_FF2 + n0 + lane, sb[r]); }
    }
    const int c = lane & 7;
#pragma unroll
    for (int j = 0; j < 4; ++j) { const int n = (lane >> 3) + 8 * j; const LAS float* s = scr + (8 * c) * 33 + n;
        u32x4 o; o.x = cvt_pk_bf16(s[0 * 33], s[1 * 33]); o.y = cvt_pk_bf16(s[2 * 33], s[3 * 33]); o.z = cvt_pk_bf16(s[4 * 33], s[5 * 33]); o.w = cvt_pk_bf16(s[6 * 33], s[7 * 33]);
        *(u32x4*)(WT + (size_t)(d0 + n) * K + k0 + 8 * c) = o; }
    LDS_WAIT(); asm volatile("" ::: "memory");
}

__device__ __forceinline__ void gemv_items(const Args& a, LAS unsigned char* lds, int blk_lo, int blk_hi, int widx, int nwork, int tid) {
    LAS float* sc = (LAS float*)lds;
    LAS float* red = (LAS float*)(lds + 4096);
    float* mod = (float*)(a.ws + WS_MOD);
    const int nitems = (blk_hi - blk_lo) * 8;
    for (int it = widx; it < nitems; it += nwork) {
        const int cb = blk_lo + (it >> 3), ks = it & 7, l = cb / 96, j0 = (cb % 96) * 128, k0 = ks * 256;
        __syncthreads();
        for (int i = tid; i < 3 * 256; i += 512) { const int r = i >> 8, k = k0 + (i & 255); const float v = (r == 0) ? a.in[I_CCTX][k] : a.in[I_C][(r - 1) * 2048 + k]; sc[i] = v / (1.f + __expf(-v)); }
        __syncthreads();
        const int cq = tid & 31, kg = tid >> 5;
        float acc[3][4];
#pragma unroll
        for (int r = 0; r < 3; ++r)
#pragma unroll
            for (int e = 0; e < 4; ++e) acc[r][e] = 0.f;
        const float* wp = a.in[I_WMOD] + ((size_t)l * 2048 + k0) * 12288 + j0 + 4 * cq;
#pragma unroll 8
        for (int k = kg; k < 256; k += 16) { const f32x4 w = *(const f32x4*)(wp + (size_t)k * 12288);
#pragma unroll
            for (int r = 0; r < 3; ++r) { const float s_ = sc[r * 256 + k]; acc[r][0] += s_ * w.x; acc[r][1] += s_ * w.y; acc[r][2] += s_ * w.z; acc[r][3] += s_ * w.w; } }
#pragma unroll
        for (int r = 0; r < 3; ++r)
#pragma unroll
            for (int e = 0; e < 4; ++e) red[(kg * 32 + cq) * 12 + r * 4 + e] = acc[r][e];
        __syncthreads();
        if (tid < 384) { const int r = tid >> 7, jj = tid & 127, cq2 = jj >> 2, e = jj & 3; float s_ = 0.f;
#pragma unroll
            for (int kg2 = 0; kg2 < 16; ++kg2) s_ += red[(kg2 * 32 + cq2) * 12 + r * 4 + e];
            if (ks == 0) s_ += a.in[I_BMOD][l * 12288 + j0 + jj];
            atomicAdd(mod + (size_t)(l * 3 + r) * 12288 + j0 + jj, s_); }
    }
    __syncthreads();
}
constexpr int CI_E = 32 * (IN_EVEN / 32), CI_O = 32 * (IN_ODD / 32), CI_W = 32 * 64, CI_U = 32 * (D_FF2 / 32), CI_D = 88 * 64;
constexpr int CV_E = 0, CV_O = CV_E + CI_E, CV_W0 = CV_O + CI_O, CV_W1 = CV_W0 + CI_W, CV_U0 = CV_W1 + CI_W, CV_U1 = CV_U0 + CI_U, CV_D0 = CV_U1 + CI_U, CV_D1 = CV_D0 + CI_D, CV_END = CV_D1 + CI_D;
__device__ __forceinline__ void convert_one(const Args& a, LAS float* scr, int it, int lane) {
    int r = it;
    if (r < CI_E) { p0_transpose_item(a.in[I_WINE], 2048, IN_EVEN, (bf16_t*)(a.ws + WS_WINE), scr, r, lane); return; } r -= CI_E;
    if (r < CI_O) { p0_transpose_item(a.in[I_WINO], 2048, IN_ODD, (bf16_t*)(a.ws + WS_WINO), scr, r, lane); return; } r -= CI_O;
    if (r < 2 * CI_W) { const int l = r / CI_W; p0_transpose_item(a.in[I_WOUT] + (size_t)l * 2048 * 2048, 2048, 2048, (bf16_t*)(a.ws + WS_WOUT) + (size_t)l * 2048 * 2048, scr, r % CI_W, lane); return; } r -= 2 * CI_W;
    if (r < 2 * CI_U) { const int l = r / CI_U; p0_transpose_item(a.in[I_WUP] + (size_t)l * 2048 * D_FF2, 2048, D_FF2, (bf16_t*)(a.ws + WS_WUP) + (size_t)l * 2048 * D_FF2, scr, r % CI_U, lane, true,
            (const float*)(a.ws + WS_MOD) + (size_t)l * 3 * 12288 + 3 * 2048, (float*)(a.ws + WS_BIAS) + (size_t)l * 3 * D_FF2); return; } r -= 2 * CI_U;
    { const int l = r / CI_D; p0_transpose_item(a.in[I_WDN] + (size_t)l * D_FF * 2048, D_FF, 2048, (bf16_t*)(a.ws + WS_WDN) + (size_t)l * D_FF * 2048, scr, r % CI_D, lane); }
}
__device__ __forceinline__ void convert_items(const Args& a, LAS unsigned char* lds, int lo, int hi, int widx, int nwork, int lane, int wave) {
    LAS float* scr = (LAS float*)(lds + wave * 16384);
    for (int it = lo + widx * 8 + wave; it < hi; it += nwork * 8) convert_one(a, scr, it, lane);
}

__device__ __forceinline__ void p0_prologue(const Args& a, LAS unsigned char* lds, int tid, int lane, int wave, int G) {
    if (blockIdx.x == 0) { float* rt = (float*)(a.ws + WS_ROPE);
        for (int i = tid; i < 1024; i += 512) { const int pos = i >> 4, f = i & 15; const float rev = (float)pos * exp2f(-(float)f * 0.8304820237218406f) * 0.15915494309189535f; const float fr_ = rev - floorf(rev);
            rt[2 * i] = __builtin_amdgcn_cosf(fr_); rt[2 * i + 1] = __builtin_amdgcn_sinf(fr_); } }
    gemv_items(a, lds, 0, 32, (int)blockIdx.x, G, tid);
    convert_items(a, lds, CV_E, CV_O, (int)blockIdx.x, G, lane, wave);
    convert_items(a, lds, CV_W0, CV_W1, (int)blockIdx.x, G, lane, wave);
#if !DEFER_PROLOGUE
    gemv_items(a, lds, 32, 192, (int)blockIdx.x, G, tid);
    convert_items(a, lds, CV_O, CV_W0, (int)blockIdx.x, G, lane, wave);
    convert_items(a, lds, CV_W1, CV_END, (int)blockIdx.x, G, lane, wave);
#endif
}

template <bool XB>
__device__ __forceinline__ void norm_phase(const void* x0, const void* x1, const float* g, const float* mod_l, int shift_idx, bf16_t* h, int lane, int wave, int G,
                                           const bf16_t* part = nullptr, const float* pgate = nullptr, bf16_t* xw = nullptr) {
    const int gw = blockIdx.x * 8 + wave, NGW = G * 8;
    for (int m = gw; m < MTOK; m += NGW) {
        const char* xr = (const char*)((m < NCTX) ? x0 : x1) + (size_t)((m < NCTX) ? m : m - NCTX) * D_MODEL * (XB ? 2 : 4);
        const int cond = (m < NCTX) ? 0 : 1 + ((m - NCTX) >> 10);
        const float* sh = mod_l + (size_t)cond * 12288 + shift_idx * 2048; const float* scl = sh + 2048;
        f32x4 v[8]; float ss = 0.f;
        u32x2 xb[8]; f32x4 xf[8]; f32x4 gg[8], s1[8], s0[8];
#pragma unroll
        for (int j = 0; j < 8; ++j) { if (XB) xb[j] = *(const u32x2*)(xr + 8 * (64 * j + lane)); else xf[j] = *(const f32x4*)(xr + 16 * (64 * j + lane)); }
        const bool comb = XB && part != nullptr && m >= NCTX;
#pragma unroll
        for (int j = 0; j < 8; ++j) { if (XB) v[j] = (f32x4){bf_lo(xb[j].x), bf_hi(xb[j].x), bf_lo(xb[j].y), bf_hi(xb[j].y)}; else v[j] = xf[j]; }
        if (comb) {
#pragma unroll
            for (int jh = 0; jh < 2; ++jh) { u32x2 pw[4][4]; f32x4 pg[4];
#pragma unroll
                for (int j4 = 0; j4 < 4; ++j4) { const int k = 4 * (64 * (4 * jh + j4) + lane); pg[j4] = *(const f32x4*)(pgate + (size_t)cond * 12288 + k);
#pragma unroll
                    for (int q = 0; q < 4; ++q) pw[j4][q] = *(const u32x2*)(part + ((size_t)q * NLAT + (m - NCTX)) * D_MODEL + k); }
#pragma unroll
                for (int j4 = 0; j4 < 4; ++j4) { f32x4 ps = (f32x4){0.f, 0.f, 0.f, 0.f};
#pragma unroll
                    for (int q = 0; q < 4; ++q) ps += (f32x4){bf_lo(pw[j4][q].x), bf_hi(pw[j4][q].x), bf_lo(pw[j4][q].y), bf_hi(pw[j4][q].y)};
                    v[4 * jh + j4] += pg[j4] * ps; }
                __builtin_amdgcn_sched_barrier(0); }
        }
#pragma unroll
        for (int j = 0; j < 8; ++j) ss += (v[j].x * v[j].x + v[j].y * v[j].y) + (v[j].z * v[j].z + v[j].w * v[j].w);
        __builtin_amdgcn_sched_barrier(0);
#pragma unroll
        for (int j = 0; j < 8; ++j) { const int k = 4 * (64 * j + lane); gg[j] = *(const f32x4*)(g + k); s1[j] = *(const f32x4*)(scl + k); s0[j] = *(const f32x4*)(sh + k); }
        const float rstd = rsqrtf(wave_sum(ss) * (1.f / D_MODEL) + EPS);
#pragma unroll
        for (int j = 0; j < 8; ++j) { const int k = 4 * (64 * j + lane);
            if (comb) { u32x2 o; o.x = cvt_pk_bf16(v[j].x, v[j].y); o.y = cvt_pk_bf16(v[j].z, v[j].w); *(u32x2*)(xw + (size_t)m * D_MODEL + k) = o; }
            const f32x4 y = v[j] * rstd * gg[j] * (s1[j] + 1.f) + s0[j];
            u32x2 o; o.x = cvt_pk_bf16(y.x, y.y); o.y = cvt_pk_bf16(y.z, y.w);
            *(u32x2*)(h + (size_t)m * D_MODEL + k) = o; }
    }
}

__device__ __forceinline__ void conv_fixup(const float* eraw, const float* ecv, const float* cw, bf16_t* act, unsigned* cnt, int tid, int G) {
    for (int i = blockIdx.x * 512 + tid; i < 12 * D_FF; i += G * 512) {
        const int r = i / D_FF, c = i - r * D_FF, bd = r >> 1, side = r & 1;
        const int ltl = bd + bd / 3, pn = c >> 7, w = c & 127;
        const int lt_own = ltl + side, lt_nb = ltl + 1 - side;
        const size_t o_own = ((size_t)(lt_own * 2 + (1 - side)) * 44 + pn) * 256 + w, o_nb = ((size_t)(lt_nb * 2 + side) * 44 + pn) * 256 + w;
        const int tap = side ? 0 : 2;
        const float gg = ecv[o_own] + cw[(size_t)tap * D_FF2 + c] * eraw[o_nb];
        const float vv = ecv[o_own + 128] + cw[(size_t)tap * D_FF2 + D_FF + c] * eraw[o_nb + 128];
        const float o = gg * sigmoidf_(gg) * vv;
        *(unsigned short*)(act + (size_t)(NCTX + 256 * lt_own + (side ? 0 : 255)) * D_FF + c) = (unsigned short)f2bf(o);
    }
    const bool had = (int)blockIdx.x * 512 < 12 * D_FF;
    if (had) { asm volatile("s_waitcnt vmcnt(0)" ::: "memory"); __syncthreads(); }
    if (tid == 0) {
        if (had) { __builtin_amdgcn_fence(__ATOMIC_RELEASE, "agent"); asm volatile("s_waitcnt vmcnt(0)" ::: "memory"); }
        (void)__hip_atomic_fetch_add(cnt, 1u, __ATOMIC_RELAXED, __HIP_MEMORY_SCOPE_AGENT);
    }
}

__device__ __forceinline__ void combine_phase(const bf16_t* hf, const bf16_t* hb, const bf16_t* proj, const float* mlg, bf16_t* mix, int lane, int wave, int G) {
    const int gw = blockIdx.x * 8 + wave, NGW = G * 8;
    float gg[16]; load8_f32(mlg + 16 * lane, gg); load8_f32(mlg + 16 * lane + 8, gg + 8);
    u32x4 ra[2], rb[2], ro[2];
#define CMB_LOAD(mm) do { ra[0] = *(const u32x4*)(hf + (size_t)(mm) * 1024 + 16 * lane); ra[1] = *(const u32x4*)(hf + (size_t)(mm) * 1024 + 16 * lane + 8); \
        rb[0] = *(const u32x4*)(hb + (size_t)(mm) * 1024 + 16 * lane); rb[1] = *(const u32x4*)(hb + (size_t)(mm) * 1024 + 16 * lane + 8); \
        ro[0] = *(const u32x4*)(proj + (size_t)(mm) * IN_EVEN_PAD + 6144 + 16 * lane); ro[1] = *(const u32x4*)(proj + (size_t)(mm) * IN_EVEN_PAD + 6144 + 16 * lane + 8); } while (0)
    if (gw < MTOK) CMB_LOAD(gw);
    for (int m = gw; m < MTOK; m += NGW) {
        float v[16], ob[16]; float ss = 0.f;
        { float fb[16]; unpack8(ra[0], v); unpack8(ra[1], v + 8); unpack8(rb[0], fb); unpack8(rb[1], fb + 8); unpack8(ro[0], ob); unpack8(ro[1], ob + 8);
#pragma unroll
          for (int j = 0; j < 16; ++j) v[j] += fb[j]; }
        asm volatile("" ::: "memory");
        if (m + NGW < MTOK) CMB_LOAD(m + NGW);
#pragma unroll
        for (int j = 0; j < 16; ++j) ss += v[j] * v[j];
        ss += __shfl_xor(ss, 1); ss += __shfl_xor(ss, 2); ss += __shfl_xor(ss, 4);
        const float rstd = rsqrtf(ss * (1.f / 128.f) + EPS);
        float o[16];
#pragma unroll
        for (int j = 0; j < 16; ++j) o[j] = sigmoidf_(ob[j]) * (v[j] * rstd * gg[j]);
        bf16_t* op = mix + (size_t)m * D_MODEL + 1024 + 16 * lane;
        *(u32x4*)op = pack8(o); *(u32x4*)(op + 8) = pack8(o + 8);
    }
#undef CMB_LOAD
}

constexpr int AT_BUF = 71680, AT_K = 0, AT_V = 34816, AT_RPB = 143360, AT_KP = 272, AT_VP = 288;
__device__ __forceinline__ int clampi(int v, int lo, int hi) { return v < lo ? lo : (v > hi ? hi : v); }

template <int MODE>
__device__ __forceinline__ void attn_unit(const Args& a, LAS unsigned char* lds, int unit, int tid, int lane, int wave) {
    asm volatile("" : "+v"(tid), "+v"(lane)); asm volatile("" : "+s"(wave));
    constexpr bool ODD = MODE >= 2, LAT = (MODE & 1) != 0;
    constexpr int LD = ODD ? IN_ODD : IN_EVEN_PAD;
    const int fr = lane & 15, g = lane >> 4, tq = (lane >> 2) & 3, tp = lane & 3;
    const bf16_t* proj = (const bf16_t*)(a.ws + WS_PROJ);
    bf16_t* mix = (bf16_t*)(a.ws + WS_MIX);
    int b, h, u;
    if (!LAT) { b = unit >> 3; h = unit & 7; u = 0; } else { b = unit >> 6; h = (unit >> 3) & 7; u = unit & 7; }
    const int tok0 = LAT ? NCTX + b * 1024 : b * 256;
    const float* gq = a.in[ODD ? I_DGQ : I_NAGQ]; const float* gk = a.in[ODD ? I_DGK : I_NAGK];
    int n_own, n_cache, rlo = 0;
    if (!LAT) { n_own = 2; n_cache = 0; }
    else if (MODE == 1) { rlo = clampi(2 * u - 4, 0, 8); const int rhi = clampi(2 * u + 1 - 4, 0, 8) + 7; n_own = (rhi - rlo + 2) >> 1; n_cache = 4; }
    else { n_own = 8; n_cache = 4; }
    const int ntile = n_own + n_cache;
    const int r_w = 2 * u + (wave >> 2), r0w = clampi(r_w - 4, 0, 8), qc = 16 * (wave & 3) + fr;
    float lam = 0.f;
#define AT_LAM() do { if (ODD) { const float* dl = a.in[I_DLAM]; const float p01 = wave_sum(dl[lane] * dl[64 + lane]), p23 = wave_sum(dl[128 + lane] * dl[192 + lane]); lam = __expf(p01) - __expf(p23) + LAM_INIT1; } } while (0)
    if (MODE == 1) { LAS float* rp = (LAS float*)(lds + AT_RPB); for (int i = tid; i < 15 * 31; i += 512) rp[i] = a.in[I_RPB][h * 465 + i] * 1.4426950408889634f; }
    float* outk = a.out + (ODD ? O_DK : O_NAK) + (size_t)(b * 8 + h) * 256 * 128;
    float* outv = a.out + (ODD ? O_DV : O_NAV) + (size_t)(b * 8 + h) * 256 * 128;
    const float* cK = a.in[ODD ? I_CDK : I_CNAK] + (size_t)(b * 8 + h) * 512 * 128;
    const float* cV = a.in[ODD ? I_CDV : I_CNAV] + (size_t)(b * 8 + h) * 512 * 128;

    f32x4 raw_[2][4];
    float ggk_[8] = {0.f, 0.f, 0.f, 0.f, 0.f, 0.f, 0.f, 0.f};
#define AT_KBASE(tt) ((tt) < n_own ? ((MODE == 1) ? (rlo + 2 * (tt)) * 64 : 128 * (tt)) : 128 * ((tt) - n_own))
#define AT_LOAD_HALF(tt, hf) AT_LOAD_HALF_R(tt, hf, raw_)
#define AT_LOAD_HALF_R(tt, hf, RW) do { const int kb0_ = AT_KBASE(tt) + 64 * (hf); \
        if ((tt) < n_own) { _Pragma("unroll") for (int i = 0; i < 2; ++i) { const int p_ = tid + 512 * i; const bf16_t* src = proj + (size_t)(tok0 + kb0_ + (p_ >> 4)) * LD + h * 128 + 8 * (p_ & 15); \
                RW[i][0] = *(const f32x4*)(src + 1024); RW[i][1] = *(const f32x4*)(src + 2048); } } \
        else if (LAT) { _Pragma("unroll") for (int i = 0; i < 2; ++i) { const int p_ = tid + 512 * i; const size_t o_ = (size_t)(kb0_ + (p_ >> 4)) * 128 + 8 * (p_ & 15); \
                RW[i][0] = *(const f32x4*)(cK + o_); RW[i][1] = *(const f32x4*)(cK + o_ + 4); RW[i][2] = *(const f32x4*)(cV + o_); RW[i][3] = *(const f32x4*)(cV + o_ + 4); } } } while (0)
#define AT_WRITE_HALF(tt, hf) AT_WRITE_HALF_R(tt, hf, raw_, false)
#define AT_WRITE_HALF_R(tt, hf, RW, PREG) do { const bool own_ = (tt) < n_own; const int kb0_ = AT_KBASE(tt) + 64 * (hf); LAS unsigned char* bufp_ = lds + ((tt) & 1) * AT_BUF; \
        _Pragma("unroll") for (int i = 0; i < 2; ++i) { const int p_ = tid + 512 * i, row_ = p_ >> 4, c_ = p_ & 15; float kv[8]; \
            if (own_) { unpack8(__builtin_bit_cast(u32x4, RW[i][0]), kv); float ss_ = 0.f; \
                _Pragma("unroll") for (int j = 0; j < 8; ++j) ss_ += kv[j] * kv[j]; \
                ss_ += __shfl_xor(ss_, 1); ss_ += __shfl_xor(ss_, 2); ss_ += __shfl_xor(ss_, 4); float rs_; \
                if (!ODD) { ss_ += __shfl_xor(ss_, 8); rs_ = rsqrtf(ss_ * (1.f / 128.f) + EPS); } else rs_ = rsqrtf(ss_ * (1.f / 64.f) + EPS); \
                float gg_[8]; if (PREG) { _Pragma("unroll") for (int j = 0; j < 8; ++j) gg_[j] = ggk_[j]; } else load8_f32(gk + (ODD ? 8 * (c_ & 7) : 8 * c_), gg_); \
                _Pragma("unroll") for (int j = 0; j < 8; ++j) kv[j] *= rs_ * gg_[j]; \
                if (!LAT) { float vv_[8]; unpack8(__builtin_bit_cast(u32x4, RW[i][1]), vv_); store8_f32(outk + (size_t)(kb0_ + row_) * 128 + 8 * c_, kv); store8_f32(outv + (size_t)(kb0_ + row_) * 128 + 8 * c_, vv_); } \
                if (MODE == 3) { const int kpos_ = kb0_ + row_; const int pos_ = ((c_ & 7) >> 2) ? (kpos_ & 63) : (kpos_ >> 6); const float* rt_ = (const float*)(a.ws + WS_ROPE) + (pos_ * 16 + 8 * (c_ & 1)) * 2; \
                    _Pragma("unroll") for (int j2 = 0; j2 < 4; ++j2) { const f32x4 t4_ = *(const f32x4*)(rt_ + 4 * j2); \
                        _Pragma("unroll") for (int e = 0; e < 2; ++e) { const int j = 2 * j2 + e; const float cs_ = t4_[2 * e], sn_ = t4_[2 * e + 1]; const float pr_ = __shfl_xor(kv[j], 2); \
                            kv[j] = ((c_ & 3) < 2) ? kv[j] * cs_ - pr_ * sn_ : kv[j] * cs_ + pr_ * sn_; } } } \
                *(LAS u32x4*)(bufp_ + AT_V + (64 * (hf) + row_) * AT_VP + c_ * 16) = __builtin_bit_cast(u32x4, RW[i][1]); \
            } else { float vv_[8]; \
                _Pragma("unroll") for (int j = 0; j < 4; ++j) { kv[j] = RW[i][0][j]; kv[4 + j] = RW[i][1][j]; vv_[j] = RW[i][2][j]; vv_[4 + j] = RW[i][3][j]; } \
                *(LAS u32x4*)(bufp_ + AT_V + (64 * (hf) + row_) * AT_VP + c_ * 16) = pack8(vv_); } \
            *(LAS u32x4*)(bufp_ + AT_K + (64 * (hf) + row_) * AT_KP + c_ * 16) = pack8(kv); } } while (0)

#define AT_QLOAD(qi_, QR) do { const bf16_t* qp = proj + (size_t)(tok0 + (qi_)) * LD + h * 128 + 8 * g; _Pragma("unroll") for (int ks = 0; ks < 4; ++ks) QR[ks] = *(const u32x4*)(qp + 32 * ks); } while (0)
#define AT_QPREP(qi_) do { u32x4 qr1_[4]; AT_QLOAD(qi_, qr1_); AT_QPREP_R(qi_, qr1_); } while (0)
#define AT_QPREP_R(qi_, QR) do { float qv[4][8]; \
        _Pragma("unroll") for (int ks = 0; ks < 4; ++ks) unpack8(QR[ks], qv[ks]); \
        if (!ODD) { float ss = 0.f; \
            _Pragma("unroll") for (int ks = 0; ks < 4; ++ks) _Pragma("unroll") for (int j = 0; j < 8; ++j) ss += qv[ks][j] * qv[ks][j]; \
            ss += __shfl_xor(ss, 16); ss += __shfl_xor(ss, 32); const float rs = rsqrtf(ss * (1.f / 128.f) + EPS) * (0.08838834764831845f * 1.4426950408889634f);       \
            _Pragma("unroll") for (int ks = 0; ks < 4; ++ks) { float gg[8]; load8_f32(gq + 32 * ks + 8 * g, gg); _Pragma("unroll") for (int j = 0; j < 8; ++j) qv[ks][j] *= rs * gg[j]; } \
        } else { float s0_ = 0.f, s1_ = 0.f; \
            _Pragma("unroll") for (int j = 0; j < 8; ++j) { s0_ += qv[0][j] * qv[0][j] + qv[1][j] * qv[1][j]; s1_ += qv[2][j] * qv[2][j] + qv[3][j] * qv[3][j]; } \
            s0_ += __shfl_xor(s0_, 16); s0_ += __shfl_xor(s0_, 32); s1_ += __shfl_xor(s1_, 16); s1_ += __shfl_xor(s1_, 32); \
            const float r0_ = rsqrtf(s0_ * (1.f / 64.f) + EPS) * (0.125f * 1.4426950408889634f), r1_ = rsqrtf(s1_ * (1.f / 64.f) + EPS) * (0.125f * 1.4426950408889634f); \
            _Pragma("unroll") for (int ks = 0; ks < 4; ++ks) { float gg[8]; load8_f32(gq + 32 * (ks & 1) + 8 * g, gg); _Pragma("unroll") for (int j = 0; j < 8; ++j) qv[ks][j] *= (ks < 2 ? r0_ : r1_) * gg[j]; } \
            if (LAT) { _Pragma("unroll") for (int ks = 0; ks < 4; ++ks) { const int pos = (ks & 1) ? ((qi_) & 63) : ((qi_) >> 6); const float* rt = (const float*)(a.ws + WS_ROPE) + (pos * 16 + 8 * (g & 1)) * 2; \
                    _Pragma("unroll") for (int j2 = 0; j2 < 4; ++j2) { const f32x4 t4 = *(const f32x4*)(rt + 4 * j2); \
                        _Pragma("unroll") for (int e = 0; e < 2; ++e) { const int j = 2 * j2 + e; const float cs = t4[2 * e], sn = t4[2 * e + 1]; const float pr = __shfl_xor(qv[ks][j], 32); \
                            qv[ks][j] = (g < 2) ? qv[ks][j] * cs - pr * sn : qv[ks][j] * cs + pr * sn; } } } } } \
        _Pragma("unroll") for (int ks = 0; ks < 4; ++ks) Yq[ks] = as_bf16x8(pack8(qv[ks])); } while (0)

#define ATB 8
#define MLB 4
#define AT_SUBTILE(bf_, sub_, local_, kr_) do { \
        bool valid_ = true; if (MODE == 1 && (local_)) valid_ = ((kr_) >= r0w) && ((kr_) < r0w + 8); \
        if (valid_) { const LAS unsigned char* kb_p = lds + (bf_) * AT_BUF + AT_K + (64 * (sub_) + fr) * AT_KP + (8 * g) * 2; \
            const LAS unsigned char* vb_p = lds + (bf_) * AT_BUF + AT_V + (64 * (sub_) + 4 * g + tq) * AT_VP + (4 * tp) * 2; \
            f32x4 s0[4], s1[4]; \
            _Pragma("unroll") for (int kb = 0; kb < 4; ++kb) { s0[kb] = (f32x4){0.f, 0.f, 0.f, 0.f}; s1[kb] = (f32x4){0.f, 0.f, 0.f, 0.f}; } \
            if (false) { \
            _Pragma("unroll") for (int kb = 0; kb < 4; ++kb) _Pragma("unroll") for (int ks = 0; ks < 4; ++ks) { const bf16x8 kf = *(const LAS bf16x8*)(kb_p + (16 * kb) * AT_KP + 64 * ks); \
                if (!ODD || ks < 2) s0[kb] = MFMA16(kf, Yq[ks], s0[kb]); else s1[kb] = MFMA16(kf, Yq[ks], s1[kb]); } \
            } else { \
            _Pragma("unroll") for (int kp = 0; kp < 16 / ATB; ++kp) { bf16x8 kf[ATB];       \
                _Pragma("unroll") for (int e = 0; e < ATB; ++e) kf[e] = *(const LAS bf16x8*)(kb_p + (16 * ((ATB * kp + e) >> 2)) * AT_KP + 64 * (e & 3)); \
                __builtin_amdgcn_sched_barrier(0); \
                _Pragma("unroll") for (int e = 0; e < ATB; ++e) { const int kb = (ATB * kp + e) >> 2, ks = e & 3; \
                    if (!ODD || ks < 2) s0[kb] = MFMA16(kf[e], Yq[ks], s0[kb]); else s1[kb] = MFMA16(kf[e], Yq[ks], s1[kb]); } \
                __builtin_amdgcn_sched_barrier(0); } } \
            if (MODE == 1 && (local_)) { const LAS float* rp = (const LAS float*)(lds + AT_RPB) + ((kr_) - r_w + 7) * 31; const int col0 = clampi(qc - 8, 0, 48); \
                float bz_[16]; \
                _Pragma("unroll") for (int kb = 0; kb < 4; ++kb) _Pragma("unroll") for (int i = 0; i < 4; ++i) { bz_[4 * kb + i] = rp[clampi(16 * kb + 4 * g + i - qc + 15, 0, 30)]; asm volatile("" : "+v"(bz_[4 * kb + i])); }     \
                _Pragma("unroll") for (int kb = 0; kb < 4; ++kb) _Pragma("unroll") for (int i = 0; i < 4; ++i) { const int kc = 16 * kb + 4 * g + i; const bool ok = (kc >= col0) && (kc < col0 + 16); \
                    s0[kb][i] = ok ? s0[kb][i] + bz_[4 * kb + i] : -1e30f; } } \
            bf16x8 P0[2], P1[2]; \
            { float mx = -1e30f; \
              _Pragma("unroll") for (int kb = 0; kb < 4; ++kb) _Pragma("unroll") for (int i = 0; i < 4; ++i) mx = fmaxf(mx, s0[kb][i]); \
              mx = fmaxf(mx, __shfl_xor(mx, 16)); mx = fmaxf(mx, __shfl_xor(mx, 32)); \
              const float mn = fmaxf(m0, mx), al = __builtin_amdgcn_exp2f(m0 - mn); m0 = mn; float rs = 0.f; \
              _Pragma("unroll") for (int kb = 0; kb < 4; ++kb) _Pragma("unroll") for (int i = 0; i < 4; ++i) { const float p = __builtin_amdgcn_exp2f(s0[kb][i] - mn); if (ODD) rs += p; s0[kb][i] = p; } \
              if (ODD) { rs += __shfl_xor(rs, 16); rs += __shfl_xor(rs, 32); l0 = l0 * al + rs; } else lacc *= al;        \
              _Pragma("unroll") for (int d = 0; d < 8; ++d) o0[d] *= al; \
              _Pragma("unroll") for (int tt = 0; tt < 2; ++tt) { u32x4 w; w.x = cvt_pk_bf16(s0[2 * tt][0], s0[2 * tt][1]); w.y = cvt_pk_bf16(s0[2 * tt][2], s0[2 * tt][3]); w.z = cvt_pk_bf16(s0[2 * tt + 1][0], s0[2 * tt + 1][1]); w.w = cvt_pk_bf16(s0[2 * tt + 1][2], s0[2 * tt + 1][3]); P0[tt] = as_bf16x8(w); } } \
            if (ODD) { float mx = -1e30f; \
              _Pragma("unroll") for (int kb = 0; kb < 4; ++kb) _Pragma("unroll") for (int i = 0; i < 4; ++i) mx = fmaxf(mx, s1[kb][i]); \
              mx = fmaxf(mx, __shfl_xor(mx, 16)); mx = fmaxf(mx, __shfl_xor(mx, 32)); \
              const float mn = fmaxf(m1, mx), al = __builtin_amdgcn_exp2f(m1 - mn); m1 = mn; float rs = 0.f; \
              _Pragma("unroll") for (int kb = 0; kb < 4; ++kb) _Pragma("unroll") for (int i = 0; i < 4; ++i) { const float p = __builtin_amdgcn_exp2f(s1[kb][i] - mn); rs += p; s1[kb][i] = p; } \
              rs += __shfl_xor(rs, 16); rs += __shfl_xor(rs, 32); l1 = l1 * al + rs; \
              _Pragma("unroll") for (int d = 0; d < 8; ++d) o1[d] *= al; \
              _Pragma("unroll") for (int tt = 0; tt < 2; ++tt) { u32x4 w; w.x = cvt_pk_bf16(s1[2 * tt][0], s1[2 * tt][1]); w.y = cvt_pk_bf16(s1[2 * tt][2], s1[2 * tt][3]); w.z = cvt_pk_bf16(s1[2 * tt + 1][0], s1[2 * tt + 1][1]); w.w = cvt_pk_bf16(s1[2 * tt + 1][2], s1[2 * tt + 1][3]); P1[tt] = as_bf16x8(w); } } \
            if (false) { \
            _Pragma("unroll") for (int d = 0; d < 8; ++d) _Pragma("unroll") for (int tt = 0; tt < 2; ++tt) { const LAS unsigned char* vp = vb_p + (32 * tt) * AT_VP + 32 * d; \
                const u32x2 lo = lds_tr(vp), hi = lds_tr(vp + 16 * AT_VP); const bf16x8 vf = as_bf16x8((u32x4){lo.x, lo.y, hi.x, hi.y}); \
                o0[d] = MFMA16(vf, P0[tt], o0[d]); if (ODD) o1[d] = MFMA16(vf, P1[tt], o1[d]); } \
            } else { \
            _Pragma("unroll") for (int tb = 0; tb < 16 / ATB; ++tb) { bf16x8 vf[ATB]; \
                _Pragma("unroll") for (int e = 0; e < ATB; ++e) { const int tt = (ATB * tb + e) >> 3, d = (ATB * tb + e) & 7; const LAS unsigned char* vp = vb_p + (32 * tt) * AT_VP + 32 * d; \
                    const u32x2 lo = lds_tr(vp), hi = lds_tr(vp + 16 * AT_VP); vf[e] = as_bf16x8((u32x4){lo.x, lo.y, hi.x, hi.y}); } \
                __builtin_amdgcn_sched_barrier(0); \
                if (!ODD && ((ATB * tb) & 7) == 0) lacc = MFMA16(as_bf16x8((u32x4){0x3f803f80u, 0x3f803f80u, 0x3f803f80u, 0x3f803f80u}), P0[(ATB * tb) >> 3], lacc);        \
                _Pragma("unroll") for (int e = 0; e < ATB; ++e) { const int tt = (ATB * tb + e) >> 3, d = (ATB * tb + e) & 7; o0[d] = MFMA16(vf[e], P0[tt], o0[d]); if (ODD) o1[d] = MFMA16(vf[e], P1[tt], o1[d]); } \
                __builtin_amdgcn_sched_barrier(0); } } } } while (0)

#define AT_FINAL(qi_) do { bf16_t* op = mix + (size_t)(tok0 + (qi_)) * D_MODEL + h * 128 + 4 * g; \
        if (!ODD) { const float inv = 1.f / lacc[0]; \
            _Pragma("unroll") for (int d = 0; d < 8; ++d) { u32x2 w; w.x = cvt_pk_bf16(o0[d][0] * inv, o0[d][1] * inv); w.y = cvt_pk_bf16(o0[d][2] * inv, o0[d][3] * inv); *(u32x2*)(op + 16 * d) = w; } \
        } else { const float i0 = 1.f / l0, i1 = lam / l1; float ss = 0.f; \
            _Pragma("unroll") for (int d = 0; d < 8; ++d) _Pragma("unroll") for (int i = 0; i < 4; ++i) { const float v = o0[d][i] * i0 - o1[d][i] * i1; o0[d][i] = v; ss += v * v; } \
            ss += __shfl_xor(ss, 16); ss += __shfl_xor(ss, 32); const float rs = rsqrtf(ss * (1.f / 128.f) + EPS) * (1.f - LAM_INIT1); const float* go = a.in[I_DGOUT] + h * 128 + 4 * g; f32x4 ggo_[8]; \
            _Pragma("unroll") for (int d = 0; d < 8; ++d) ggo_[d] = *(const f32x4*)(go + 16 * d);       \
            _Pragma("unroll") for (int d = 0; d < 8; ++d) { const f32x4 gg = ggo_[d]; u32x2 w; w.x = cvt_pk_bf16(o0[d][0] * rs * gg.x, o0[d][1] * rs * gg.y); w.y = cvt_pk_bf16(o0[d][2] * rs * gg.z, o0[d][3] * rs * gg.w); *(u32x2*)(op + 16 * d) = w; } } } while (0)
#define AT_INIT() do { _Pragma("unroll") for (int d = 0; d < 8; ++d) { o0[d] = (f32x4){0.f, 0.f, 0.f, 0.f}; o1[d] = (f32x4){0.f, 0.f, 0.f, 0.f}; } m0 = -1e30f; m1 = -1e30f; l0 = 0.f; l1 = 0.f; lacc = (f32x4){0.f, 0.f, 0.f, 0.f}; } while (0)

    bf16x8 Yq[4];
    f32x4 o0[8], o1[8];
    float m0, m1, l0, l1; f32x4 lacc;
    __syncthreads();
    if (!LAT) {
        f32x4 rawc[4][2][4]; u32x4 qr_[4];
#pragma unroll
        for (int t2 = 0; t2 < 2; ++t2)
#pragma unroll
            for (int hf = 0; hf < 2; ++hf) AT_LOAD_HALF_R(t2, hf, rawc[2 * t2 + hf]);
        load8_f32(gk + (ODD ? 8 * (lane & 7) : 8 * (lane & 15)), ggk_);
        AT_QLOAD(16 * wave + fr, qr_);
        AT_LAM();
#pragma unroll
        for (int t2 = 0; t2 < 2; ++t2)
#pragma unroll
            for (int hf = 0; hf < 2; ++hf) AT_WRITE_HALF_R(t2, hf, rawc[2 * t2 + hf], true);
        __syncthreads();
        for (int qb = 0; qb < 2; ++qb) {
            const int qi = 128 * qb + 16 * wave + fr;
            AT_QPREP_R(qi, qr_); AT_INIT();
if (ODD) {
#pragma unroll 1
                for (int st = 0; st < 4; ++st) AT_SUBTILE(st >> 1, st & 1, false, 0);
            } else {
#pragma unroll
                for (int st = 0; st < 4; ++st) AT_SUBTILE(st >> 1, st & 1, false, 0);
            }
            if (qb == 0) AT_QLOAD(128 + 16 * wave + fr, qr_);
            AT_FINAL(qi);
        }
    } else {
        const int qi = 128 * u + 16 * wave + fr;
        AT_LOAD_HALF(0, 0); AT_LAM(); AT_WRITE_HALF(0, 0); AT_LOAD_HALF(0, 1); AT_WRITE_HALF(0, 1);
        AT_QPREP(qi); AT_INIT();
        __syncthreads();
        for (int t = 0; t < ntile; ++t) {
            const bool more = t + 1 < ntile, local = (MODE == 1) && (t < n_own);
            const int kr0 = rlo + 2 * t;
            if (more) AT_LOAD_HALF(t + 1, 0);
            AT_SUBTILE(t & 1, 0, local, kr0);
            if (more) { AT_WRITE_HALF(t + 1, 0); AT_LOAD_HALF(t + 1, 1); }
            AT_SUBTILE(t & 1, 1, local, kr0 + 1);
            if (more) AT_WRITE_HALF(t + 1, 1);
            __syncthreads();
        }
        AT_FINAL(qi);
    }
#undef AT_KBASE
#undef AT_LOAD_HALF
#undef AT_WRITE_HALF
#undef AT_QPREP
#undef AT_QPREP_R
#undef AT_QLOAD
#undef AT_LAM
#undef AT_LOAD_HALF_R
#undef AT_WRITE_HALF_R
#undef AT_SUBTILE
#undef AT_FINAL
#undef AT_INIT
}

constexpr int ML_KT = 0, ML_KW = 34816, ML_VT = 71680, ML_CT = 108544, ML_ARR = 143360, ML_P = 272, ML_Q = 288;
__device__ __forceinline__ void mlstm_unit(const Args& a, LAS unsigned char* lds, bool lat, int idx, int tid, int lane, int wave) {
    asm volatile("" : "+v"(tid), "+v"(lane)); asm volatile("" : "+s"(wave));
    const int fr = lane & 15, g = lane >> 4;
    const bf16_t* proj = (const bf16_t*)(a.ws + WS_PROJ);
    const float* gates = (const float*)(a.ws + WS_GATES);
    const int b = idx >> 4, h = (idx >> 1) & 7, dir = idx & 1;
    const int S = lat ? 1024 : 256, nc = S / 128, tok0 = lat ? NCTX + b * 1024 : b * 256;
    bf16_t* hbuf = (bf16_t*)(a.ws + (dir ? WS_HB : WS_HF));
    LAS float* BB = (LAS float*)(lds + ML_ARR); LAS float* AA = BB + 128; LAS float* PM = BB + 256; LAS float* WS_ = BB + 384; LAS float* NN = BB + 512; LAS float* SCAL = BB + 640;
    const size_t sidx = (size_t)((b * 2 + dir) * 8 + h);
    const int jrow = 16 * wave + fr;
#define ML_TOK(c, p) (tok0 + (dir ? (S - 1 - (128 * (c) + (p))) : (128 * (c) + (p))))
#define ML_GATE_LOAD(cc) do { \
        const float* g0 = gates + (size_t)ML_TOK(cc, 2 * lane) * 32 + (2 * dir) * 8 + h; const float* g1 = gates + (size_t)ML_TOK(cc, 2 * lane + 1) * 32 + (2 * dir) * 8 + h; \
        gpre[0] = g0[0]; gpre[1] = g0[8]; gpre[2] = g1[0]; gpre[3] = g1[8]; } while (0)
#define ML_GATE_SCAN(cc, m_in) do { \
        const float i0 = gpre[0], f0 = logsigmoid_(gpre[1]), i1 = gpre[2], f1 = logsigmoid_(gpre[3]); \
        const float pair = f0 + f1; float inc = pair; \
        _Pragma("unroll") for (int o = 1; o < 64; o <<= 1) { const float t_ = __shfl_up(inc, o); if (lane >= o) inc += t_; } \
        const float b0 = (inc - pair) + f0, b1 = inc, a0 = i0 - b0, a1 = i1 - b1; \
        float incm = fmaxf(a0, a1); \
        _Pragma("unroll") for (int o = 1; o < 64; o <<= 1) { const float t_ = __shfl_up(incm, o); if (lane >= o) incm = fmaxf(incm, t_); } \
        float excm = __shfl_up(incm, 1); if (lane == 0) excm = -3.0e38f; \
        const float bl_ = __shfl(inc, 63), pmf_ = __shfl(incm, 63), mn_ = bl_ + fmaxf((m_in), pmf_); \
        BB[2 * lane] = b0; BB[2 * lane + 1] = b1; AA[2 * lane] = a0; AA[2 * lane + 1] = a1; PM[2 * lane] = fmaxf(excm, a0); PM[2 * lane + 1] = incm; \
        WS_[2 * lane] = __expf(bl_ + a0 - mn_); WS_[2 * lane + 1] = __expf(bl_ + a1 - mn_); \
        if (lane == 0) { SCAL[0] = bl_; SCAL[1] = pmf_; } } while (0)
#define ML_PREFETCH(cc) do { \
        _Pragma("unroll") for (int i = 0; i < 4; ++i) { const int p_ = tid + 512 * i; const bf16_t* src = proj + (size_t)ML_TOK(cc, p_ >> 4) * IN_EVEN_PAD + h * 128 + 8 * (p_ & 15); \
            kreg[i] = *(const u32x4*)(src + 4096); } \
        } while (0)
    f32x4 cacc[8];
    float mst, nst;
    float gpre[4] = {0.f, 0.f, 0.f, 0.f};
    u32x4 kreg[4], vreg[4], qraw[4];
    __syncthreads();
    ML_PREFETCH(0);
    if (lat) {
        const float* c0 = a.in[I_SMC] + sidx * 16384 + (size_t)(16 * wave + 4 * g) * 128 + fr;
#pragma unroll
        for (int eb = 0; eb < 8; ++eb)
#pragma unroll
            for (int i = 0; i < 4; ++i) cacc[eb][i] = c0[i * 128 + 16 * eb];
        nst = a.in[I_SMN][sidx * 128 + 16 * wave + fr];
        mst = a.in[I_SMM][sidx];
    } else {
#pragma unroll
        for (int eb = 0; eb < 8; ++eb) cacc[eb] = (f32x4){0.f, 0.f, 0.f, 0.f};
        nst = 0.f;
        mst = 0.f;
    }
#pragma unroll
    for (int eb = 0; eb < 8; ++eb)
        { u32x2 w; w.x = cvt_pk_bf16(cacc[eb][0], cacc[eb][1]); w.y = cvt_pk_bf16(cacc[eb][2], cacc[eb][3]); *(LAS u32x2*)(lds + ML_CT + (16 * eb + fr) * ML_P + (16 * wave + 4 * g) * 2) = w; }
    if (g == 0) NN[16 * wave + fr] = nst;
    if (wave == 2) { ML_GATE_LOAD(0); ML_GATE_SCAN(0, mst); }
    __syncthreads();
    for (int c = 0; c < nc; ++c) {
        if (wave == 2 && c + 1 < nc) ML_GATE_LOAD(c + 1);
        const float bl = SCAL[0], mnew = bl + fmaxf(mst, SCAL[1]), aprev = __expf(bl + mst - mnew);
        const int tokj = ML_TOK(c, jrow);
#pragma unroll
        for (int i = 0; i < 4; ++i) { const int p_ = tid + 512 * i; vreg[i] = *(const u32x4*)(proj + (size_t)ML_TOK(c, p_ >> 4) * IN_EVEN_PAD + 5120 + h * 128 + 8 * (p_ & 15)); }
        { const bf16_t* qp = proj + (size_t)tokj * IN_EVEN_PAD + 3072 + h * 128 + 8 * g;
#pragma unroll
          for (int ks = 0; ks < 4; ++ks) qraw[ks] = *(const u32x4*)(qp + 32 * ks); }
#pragma unroll
        for (int i = 0; i < 4; ++i) {
            const int p = tid + 512 * i, s = p >> 4, c8 = p & 15;
            float kv[8]; unpack8(kreg[i], kv);
            const float w = WS_[s];
#pragma unroll
            for (int j = 0; j < 8; ++j) kv[j] *= 0.08838834764831845f;
            *(LAS u32x4*)(lds + ML_KT + s * ML_P + c8 * 16) = pack8(kv);
#pragma unroll
            for (int j = 0; j < 8; ++j) kv[j] *= w;
            *(LAS u32x4*)(lds + ML_KW + s * ML_Q + c8 * 16) = pack8(kv);
        }
        if (c + 1 < nc) ML_PREFETCH(c + 1);
#pragma unroll
        for (int i = 0; i < 4; ++i) {
            const int p = tid + 512 * i, s = p >> 4, c8 = p & 15;
            *(LAS u32x4*)(lds + ML_VT + s * ML_Q + c8 * 16) = vreg[i];
        }
        __syncthreads();
        const float bj = BB[jrow], mj = bj + fmaxf(mst, PM[jrow]), win = __expf(bj + mst - mj);
        f32x4 acc[8];
#pragma unroll
        for (int eb = 0; eb < 8; ++eb) acc[eb] = (f32x4){0.f, 0.f, 0.f, 0.f};
#pragma unroll
        for (int ks = 0; ks < 4; ++ks) { bf16x8 cf[8];
#pragma unroll
            for (int eb = 0; eb < 8; ++eb) cf[eb] = *(const LAS bf16x8*)(lds + ML_CT + (16 * eb + fr) * ML_P + (32 * ks + 8 * g) * 2);
            __builtin_amdgcn_sched_barrier(0);
#pragma unroll
            for (int eb = 0; eb < 8; ++eb) acc[eb] = MFMA16(cf[eb], as_bf16x8(qraw[ks]), acc[eb]);
            __builtin_amdgcn_sched_barrier(0); }
#pragma unroll
        for (int eb = 0; eb < 8; ++eb) acc[eb] *= win;
        __builtin_amdgcn_sched_barrier(0);
        float qn = 0.f;
#pragma unroll
        for (int ks = 0; ks < 4; ++ks) { float qf[8]; unpack8(qraw[ks], qf); const f32x4 n0 = *(const LAS f32x4*)(NN + 8 * g + 32 * ks), n1 = *(const LAS f32x4*)(NN + 8 * g + 32 * ks + 4);
            qn += (qf[0] * n0[0] + qf[1] * n0[1]) + (qf[2] * n0[2] + qf[3] * n0[3]) + (qf[4] * n1[0] + qf[5] * n1[1]) + (qf[6] * n1[2] + qf[7] * n1[3]); }
        qn += __shfl_xor(qn, 16); qn += __shfl_xor(qn, 32);
        float den = win * qn;
        f32x4 sc[8];
#pragma unroll
        for (int sb = 0; sb < 8; ++sb) sc[sb] = (f32x4){0.f, 0.f, 0.f, 0.f};
#pragma unroll
        for (int kq = 0; kq < 32 / MLB; ++kq) { bf16x8 kf[MLB];
#pragma unroll
            for (int e = 0; e < MLB; ++e) { const int ks = (MLB * kq + e) >> 3, sb = (MLB * kq + e) & 7; kf[e] = *(const LAS bf16x8*)(lds + ML_KT + (16 * sb + fr) * ML_P + (32 * ks + 8 * g) * 2); }
            __builtin_amdgcn_sched_barrier(0);
#pragma unroll
            for (int e = 0; e < MLB; ++e) { const int ks = (MLB * kq + e) >> 3, sb = (MLB * kq + e) & 7; sc[sb] = MFMA16(kf[e], as_bf16x8(qraw[ks]), sc[sb]); }
            __builtin_amdgcn_sched_barrier(0); }
        __builtin_amdgcn_sched_barrier(0);
        float dsum = 0.f;
#pragma unroll
        for (int sb = 0; sb < 8; ++sb)
            { const f32x4 a4 = *(const LAS f32x4*)(AA + 4 * g + 16 * sb);
#pragma unroll
              for (int i = 0; i < 4; ++i) { const int s = 16 * sb + 4 * g + i; const float w = (s <= jrow) ? __expf(bj + a4[i] - mj) * sc[sb][i] : 0.f; sc[sb][i] = w; dsum += w; } }
        dsum += __shfl_xor(dsum, 16); dsum += __shfl_xor(dsum, 32);
        den += dsum;
#pragma unroll
        for (int tt = 0; tt < 4; ++tt) { u32x4 w; w.x = cvt_pk_bf16(sc[2 * tt][0], sc[2 * tt][1]); w.y = cvt_pk_bf16(sc[2 * tt][2], sc[2 * tt][3]); w.z = cvt_pk_bf16(sc[2 * tt + 1][0], sc[2 * tt + 1][1]); w.w = cvt_pk_bf16(sc[2 * tt + 1][2], sc[2 * tt + 1][3]);
            const bf16x8 pf = as_bf16x8(w); bf16x8 vf[8];
#pragma unroll
            for (int eb = 0; eb < 8; ++eb) { const LAS unsigned char* vp = lds + ML_VT + (32 * tt + 4 * g + ((lane >> 2) & 3)) * ML_Q + (16 * eb + 4 * (lane & 3)) * 2;
                const u32x2 lo = lds_tr(vp), hi = lds_tr(vp + 16 * ML_Q); vf[eb] = as_bf16x8((u32x4){lo.x, lo.y, hi.x, hi.y}); }
            __builtin_amdgcn_sched_barrier(0);
#pragma unroll
            for (int eb = 0; eb < 8; ++eb) acc[eb] = MFMA16(vf[eb], pf, acc[eb]);
            __builtin_amdgcn_sched_barrier(0); }
        { const float dn = 1.f / fmaxf(fabsf(den), __expf(-mj)); bf16_t* hp = hbuf + (size_t)tokj * 1024 + h * 128 + 4 * g;
#pragma unroll
          for (int eb = 0; eb < 8; ++eb) { const f32x4 hv = acc[eb] * dn; u32x2 w; w.x = cvt_pk_bf16(hv[0], hv[1]); w.y = cvt_pk_bf16(hv[2], hv[3]); *(u32x2*)(hp + 16 * eb) = w; } }
        __builtin_amdgcn_sched_barrier(0);
        f32x4 nacc = (f32x4){0.f, 0.f, 0.f, 0.f};
#pragma unroll
        for (int eb = 0; eb < 8; ++eb) cacc[eb] *= aprev;
#pragma unroll
        for (int tt = 0; tt < 4; ++tt) { const LAS unsigned char* kp = lds + ML_KW + (32 * tt + 8 * g + ((lane >> 2) & 3)) * ML_Q + (16 * wave + 4 * (lane & 3)) * 2;
            const u32x2 klo = lds_tr(kp), khi = lds_tr(kp + 4 * ML_Q); const bf16x8 kf = as_bf16x8((u32x4){klo.x, klo.y, khi.x, khi.y}); bf16x8 vf[8];
#pragma unroll
            for (int eb = 0; eb < 8; ++eb) { const LAS unsigned char* vp = lds + ML_VT + (32 * tt + 8 * g + ((lane >> 2) & 3)) * ML_Q + (16 * eb + 4 * (lane & 3)) * 2;
                const u32x2 lo = lds_tr(vp), hi = lds_tr(vp + 4 * ML_Q); vf[eb] = as_bf16x8((u32x4){lo.x, lo.y, hi.x, hi.y}); }
            __builtin_amdgcn_sched_barrier(0);
            nacc = MFMA16(as_bf16x8((u32x4){0x3f803f80u, 0x3f803f80u, 0x3f803f80u, 0x3f803f80u}), kf, nacc);
#pragma unroll
            for (int eb = 0; eb < 8; ++eb) cacc[eb] = MFMA16(kf, vf[eb], cacc[eb]);
            __builtin_amdgcn_sched_barrier(0); }
        nst = aprev * nst + nacc[0];
        __syncthreads();
        if (g == 0) NN[16 * wave + fr] = nst;
#pragma unroll
        for (int eb = 0; eb < 8; ++eb) { u32x2 w; w.x = cvt_pk_bf16(cacc[eb][0], cacc[eb][1]); w.y = cvt_pk_bf16(cacc[eb][2], cacc[eb][3]); *(LAS u32x2*)(lds + ML_CT + (16 * eb + fr) * ML_P + (16 * wave + 4 * g) * 2) = w; }
        mst = mnew;
        if (wave == 2 && c + 1 < nc) ML_GATE_SCAN(c + 1, mst);
        __syncthreads();
    }
#undef ML_TOK
#undef ML_GATE_SCAN
#undef ML_GATE_LOAD
#undef ML_PREFETCH
    if (!lat) {
        float* co = a.out + O_MC + sidx * 16384 + (size_t)(16 * wave + 4 * g) * 128 + fr;
#pragma unroll
        for (int eb = 0; eb < 8; ++eb)
#pragma unroll
            for (int i = 0; i < 4; ++i) co[i * 128 + 16 * eb] = cacc[eb][i];
        if (g == 0) a.out[O_MN + sidx * 128 + 16 * wave + fr] = nst;
        if (tid == 0) a.out[O_MM + sidx] = mst;
    }
}

constexpr int SG_X = 0, SG_Y = 36864, SG_R = 71680, SG_P = 272, SG_Q = 288;
__device__ __forceinline__ void sgu_unit(const Args& a, LAS unsigned char* lds, int unit, int tid, int lane, int wave) {
    asm volatile("" : "+v"(tid), "+v"(lane)); asm volatile("" : "+s"(wave));
    const int fr = lane & 15, g = lane >> 4;
    const int ch = unit >> 3, grp = unit & 7, T0 = 128 * ch;
    const bf16_t* proj = (const bf16_t*)(a.ws + WS_PROJ);
    bf16_t* mix = (bf16_t*)(a.ws + WS_MIX);
    LAS float* RS = (LAS float*)(lds + SG_R);
    const int prow = 16 * wave + fr;
    float rss = 0.f; if (tid < 128) rss = ((const float*)(a.ws + WS_ROWSS))[T0 + tid];
    u32x4 xr[4]; f32x4 wr_[4][2];
#pragma unroll
    for (int i = 0; i < 4; ++i) { const int p = tid + 512 * i, row = p >> 4, c8 = p & 15;
        xr[i] = *(const u32x4*)(proj + (size_t)(T0 + row) * IN_ODD + 4096 + grp * 128 + 8 * c8);
        const float* wp = a.in[I_SGW] + (size_t)(grp * 128 + row) * 128 + 8 * c8; wr_[i][0] = *(const f32x4*)wp; wr_[i][1] = *(const f32x4*)(wp + 4); }
    const bf16_t* up = proj + (size_t)(T0 + prow) * IN_ODD + 3072 + grp * 128 + 4 * g;
    const float* sgg = a.in[I_SGG] + grp * 128 + 4 * g;
    u32x2 uw_[8]; f32x4 gg_[8];
#pragma unroll
    for (int cb = 0; cb < 8; ++cb) { uw_[cb] = *(const u32x2*)(up + 16 * cb); gg_[cb] = *(const f32x4*)(sgg + 16 * cb); }
    const float sb = a.in[I_SGB][grp * 128 + prow];
    __syncthreads();
    if (tid < 128) RS[tid] = rsqrtf(rss * (1.f / 1024.f) + EPS);
    __syncthreads();
#pragma unroll
    for (int i = 0; i < 4; ++i) {
        const int p = tid + 512 * i, row = p >> 4, c8 = p & 15;
        *(LAS u32x4*)(lds + SG_X + row * SG_Q + c8 * 16) = xr[i];
        float w[8];
#pragma unroll
        for (int j = 0; j < 4; ++j) { w[j] = wr_[i][0][j] * RS[8 * c8 + j]; w[4 + j] = wr_[i][1][j] * RS[8 * c8 + 4 + j]; }
        *(LAS u32x4*)(lds + SG_Y + row * SG_P + c8 * 16) = pack8(w);
    }
    __syncthreads();
    f32x4 acc[8];
    bf16x8 yf[4];
#pragma unroll
    for (int ks = 0; ks < 4; ++ks) yf[ks] = *(const LAS bf16x8*)(lds + SG_Y + (16 * wave + fr) * SG_P + (32 * ks + 8 * g) * 2);
#pragma unroll
    for (int cb = 0; cb < 8; ++cb) acc[cb] = (f32x4){0.f, 0.f, 0.f, 0.f};
#pragma unroll
    for (int ks = 0; ks < 4; ++ks) { bf16x8 xf[8];
#pragma unroll
        for (int cb = 0; cb < 8; ++cb) { const LAS unsigned char* xp = lds + SG_X + (32 * ks + 8 * g + ((lane >> 2) & 3)) * SG_Q + (16 * cb + 4 * (lane & 3)) * 2;
            const u32x2 lo = lds_tr(xp), hi = lds_tr(xp + 4 * SG_Q); xf[cb] = as_bf16x8((u32x4){lo.x, lo.y, hi.x, hi.y}); }
        __builtin_amdgcn_sched_barrier(0);
#pragma unroll
        for (int cb = 0; cb < 8; ++cb) acc[cb] = MFMA16(xf[cb], yf[ks], acc[cb]);
        __builtin_amdgcn_sched_barrier(0); }
    bf16_t* op = mix + (size_t)(T0 + prow) * D_MODEL + 1024 + grp * 128 + 4 * g;
#pragma unroll
    for (int cb = 0; cb < 8; ++cb) { const u32x2 uw = uw_[cb]; const f32x4 gg = gg_[cb];
        const float u0 = bf_lo(uw.x), u1 = bf_hi(uw.x), u2 = bf_lo(uw.y), u3 = bf_hi(uw.y);
        u32x2 w; w.x = cvt_pk_bf16(u0 * (acc[cb][0] * gg.x + sb), u1 * (acc[cb][1] * gg.y + sb)); w.y = cvt_pk_bf16(u2 * (acc[cb][2] * gg.z + sb), u3 * (acc[cb][3] * gg.w + sb));
        *(u32x2*)(op + 16 * cb) = w; }
}

#ifndef XTRA_E
#define XTRA_E 0
#endif
#ifndef XTRA_O
#define XTRA_O 0
#endif
#ifndef MIXE_REP
#define MIXE_REP 1
#endif
#ifndef MIXO_REP
#define MIXO_REP 1
#endif
#ifndef GEMM_REP
#define GEMM_REP 1
#endif
#ifndef ELT_REP
#define ELT_REP 1
#endif
#ifndef P0_REP
#define P0_REP 1
#endif
__global__ void __launch_bounds__(512, 2) trunk_fwd(Args args) {
    extern __shared__ __attribute__((aligned(16))) unsigned char lds_raw[];
    LAS unsigned char* lds = (LAS unsigned char*)lds_raw;
    volatile LAS unsigned* MISC = (volatile LAS unsigned*)(lds + LDS_MISC);
    const int G = gridDim.x;
    const int wave_s = __builtin_amdgcn_readfirstlane((int)(threadIdx.x >> 6));
#define lane ((int)__builtin_amdgcn_mbcnt_hi(~0u, __builtin_amdgcn_mbcnt_lo(~0u, 0u)))
#define wave (wave_s)
#define tid ((wave_s << 6) | lane)
    unsigned* ctl = (unsigned*)(args.ws + WS_CTL);
    for (int u = tid; u < (LDS_BYTES - LDS_MISC) / 4; u += 512) ((LAS unsigned*)(lds + LDS_MISC))[u] = 0u;
    __syncthreads();
    XcdBarrier bar = xcd_barrier_post(ctl + CW_BAR, MISC + 8);
    const int lo = args.ph_lo, hi = args.ph_hi;
    int ph = 0;
#define PHASE_BEGIN if (ph >= lo && ph < hi) {
#define PHASE_END   if (ph + 1 < hi) xcd_barrier(bar); } ++ph;


    PHASE_BEGIN for (int rep = 0; rep < P0_REP; ++rep) { if (rep > 0) xcd_barrier(bar); p0_prologue(args, lds, tid, lane, wave, G); } PHASE_END
#define IDLE_WORK(nunits, body) do { if (DEFER_PROLOGUE) { const int rem_ = (nunits) % G; if (rem_ != 0 && (int)blockIdx.x >= rem_) { const int widx = (int)blockIdx.x - rem_, nwork = G - rem_; body; } } } while (0)
#define LAYER_BODY(L) { \
        const float* mod_l = (const float*)(args.ws + WS_MOD) + (size_t)(L) * 3 * 12288; \
        const void* xin0 = ((L) == 0) ? (const void*)args.in[I_XP] : (const void*)(args.ws + WS_XRES); const void* xin1 = ((L) == 0) ? (const void*)args.in[I_XS] : (const void*)((const bf16_t*)(args.ws + WS_XRES) + (size_t)NCTX * D_MODEL); \
        PHASE_BEGIN for (int rep = 0; rep < ELT_REP; ++rep) norm_phase<(L) != 0>(xin0, xin1, args.in[I_GMIX] + (L) * 2048, mod_l, 0, (bf16_t*)(args.ws + WS_H), lane, wave, G, \
                (L) != 0 ? (const bf16_t*)(args.ws + WS_PART) : nullptr, (const float*)(args.ws + WS_MOD) + 5 * 2048, (bf16_t*)(args.ws + WS_XRES)); PHASE_END \
        PHASE_BEGIN { \
            pg8::Gemm gm{(const bf16_t*)(args.ws + WS_H), (const bf16_t*)(args.ws + ((L) == 0 ? WS_WINE : WS_WINO)), MTOK, (L) == 0 ? IN_EVEN_PAD : IN_ODD, 2048}; \
            pg8::StaticOrder S; S.init(gm.M, gm.N, G, (int)blockIdx.x); \
            pg8::EpiStore E{(bf16_t*)(args.ws + WS_PROJ), gm.N, (L) == 0 ? (float*)(args.ws + WS_GATES) : nullptr, args.in[I_MLB], 28, (L) == 0 ? 1000 : 12, 16, (float*)(args.ws + WS_ROWSS)}; \
            _Pragma("unroll") for (int rep = 0; rep < GEMM_REP; ++rep) pg8::gemm_phase<pg8::EpiStore, pg8::StaticOrder, true, true>(lds, gm, S, E); \
            if ((L) == 0) IDLE_WORK(S.nwg, { gemv_items(args, lds, 32, 96, widx, nwork, tid); convert_items(args, lds, CV_O, CV_W0, widx, nwork, lane, wave); }); \
            if ((L) == 1) IDLE_WORK(S.nwg, { gemv_items(args, lds, 128, 192, widx, nwork, tid); convert_items(args, lds, CV_W1, CV_U0, widx, nwork, lane, wave); }); \
        } PHASE_END \
        PHASE_BEGIN for (int rep = 0; rep < ((L) == 0 ? MIXE_REP : MIXO_REP); ++rep) { \
            if (rep > 0) xcd_barrier(bar); \
            unsigned* qh = ctl + ((L) == 0 ? CW_Q0 : CW_Q1) + 256 * rep; \
            const int total = ((L) == 0) ? (32 + 128 + 512 + 256 + XTRA_E) : (128 + 256 + 640 + XTRA_O); \
            for (;;) { \
                __syncthreads(); \
                if (tid == 0) MISC[0] = __hip_atomic_fetch_add(qh, 1u, __ATOMIC_RELAXED, __HIP_MEMORY_SCOPE_AGENT); \
                __syncthreads(); \
                const int u = (int)MISC[0]; \
                if (u >= total) break; \
                if ((L) == 0) { \
                    if (u < 32 || u >= 416) mlstm_unit(args, lds, u < 32, u < 32 ? u : u - 416, tid, lane, wave); \
                    else if (u < 160) attn_unit<1>(args, lds, u - 32, tid, lane, wave); \
                    else attn_unit<0>(args, lds, u - 160, tid, lane, wave); \
                } else { \
                    if (u < 128) attn_unit<3>(args, lds, u, tid, lane, wave); \
                    else if (u < 384) attn_unit<2>(args, lds, u - 128, tid, lane, wave); \
                    else sgu_unit(args, lds, (u - 384) % 640, tid, lane, wave); \
                } \
            } \
        } PHASE_END \
        if ((L) == 0) { \
            PHASE_BEGIN for (int rep = 0; rep < ELT_REP; ++rep) combine_phase((const bf16_t*)(args.ws + WS_HF), (const bf16_t*)(args.ws + WS_HB), (const bf16_t*)(args.ws + WS_PROJ), args.in[I_MLG], (bf16_t*)(args.ws + WS_MIX), lane, wave, G); PHASE_END \
        } \
        PHASE_BEGIN { \
            pg8::Gemm gm{(const bf16_t*)(args.ws + WS_MIX), (const bf16_t*)(args.ws + WS_WOUT) + (size_t)(L) * 2048 * 2048, MTOK, 2048, 2048}; \
            pg8::StaticOrder S; S.init(gm.M, gm.N, G, (int)blockIdx.x); \
            pg8::EpiRes<(L) != 0, true> E{xin0, xin1, (void*)(args.ws + WS_XRES), mod_l + 2 * 2048, nullptr, (bf16_t*)(args.ws + WS_H), args.in[I_GFFN] + (L) * 2048, mod_l + 4 * 2048, (float*)(args.ws + WS_RSF) + (L) * MTOK}; \
            _Pragma("unroll") for (int rep = 0; rep < ((L) == 0 ? GEMM_REP : 1); ++rep) pg8::gemm_phase<pg8::EpiRes<(L) != 0, true>, pg8::StaticOrder, true, true>(lds, gm, S, E); \
            if ((L) == 0) IDLE_WORK(S.nwg, { convert_items(args, lds, CV_U0, CV_U1, widx, nwork, lane, wave); convert_items(args, lds, CV_D0, CV_D1, widx, nwork, lane, wave); }); \
            if ((L) == 1) IDLE_WORK(S.nwg, { convert_items(args, lds, CV_U1, CV_D0, widx, nwork, lane, wave); convert_items(args, lds, CV_D1, CV_END, widx, nwork, lane, wave); }); \
        } PHASE_END \
        PHASE_BEGIN { \
            pg8::Gemm gm{(const bf16_t*)(args.ws + WS_H), (const bf16_t*)(args.ws + WS_WUP) + (size_t)(L) * 2048 * D_FF2, MTOK, D_FF2, 2048}; \
            pg8::StaticOrder S; S.init(gm.M, gm.N, G, (int)blockIdx.x); \
            pg8::EpiConv E{(float*)(args.ws + WS_ERAW), (float*)(args.ws + WS_ECV), (bf16_t*)(args.ws + WS_ACT), args.in[I_CONVW] + (size_t)(L) * 3 * D_FF2, args.in[I_CONVB] + (size_t)(L) * D_FF2, (LAS float*)(lds + 131072), \
                (const float*)(args.ws + WS_RSF) + (L) * MTOK, (const float*)(args.ws + WS_BIAS) + (size_t)(L) * 3 * D_FF2, (LAS float*)(lds + 139264)}; \
            _Pragma("unroll") for (int rep = 0; rep < GEMM_REP; ++rep) pg8::gemm_phase<pg8::EpiConv, pg8::StaticOrder, true, true>(lds, gm, S, E); \
            if ((L) == 0) IDLE_WORK(S.nwg, gemv_items(args, lds, 96, 128, widx, nwork, tid)); \
        } PHASE_END \
        PHASE_BEGIN { \
            pg8::Gemm gm{(const bf16_t*)(args.ws + WS_ACT), (const bf16_t*)(args.ws + WS_WDN) + (size_t)(L) * D_FF * 2048, MTOK, 2048, D_FF}; \
            pg8::SplitOrder S; S.init(gm.K, G, (int)blockIdx.x, ctl + CW_FIX + 64 * (L)); \
            S.fx_eraw = (const float*)(args.ws + WS_ERAW); S.fx_ecv = (const float*)(args.ws + WS_ECV); S.fx_cw = args.in[I_CONVW] + (size_t)(L) * 3 * D_FF2; S.fx_act = (bf16_t*)(args.ws + WS_ACT); \
            pg8::EpiRes<true, (L) == 0, true> E{(const void*)(args.ws + WS_XRES), (const void*)((const bf16_t*)(args.ws + WS_XRES) + (size_t)NCTX * D_MODEL), (L) == 0 ? (void*)(args.ws + WS_XRES) : (void*)(args.out + O_Y), mod_l + 5 * 2048, (bf16_t*)(args.ws + WS_PART), nullptr, nullptr, nullptr, nullptr}; \
            pg8::gemm_phase<pg8::EpiRes<true, (L) == 0, true>, pg8::SplitOrder, true, true>(lds, gm, S, E); \
        } PHASE_END \
    }
    LAYER_BODY(0)
    LAYER_BODY(1)
    PHASE_BEGIN {
        const int gw = blockIdx.x * 8 + wave, NGW = G * 8; const bf16_t* part = (const bf16_t*)(args.ws + WS_PART); const bf16_t* xr = (const bf16_t*)(args.ws + WS_XRES);
        const float* gfl = (const float*)(args.ws + WS_MOD) + (size_t)3 * 12288 + 5 * 2048;
        for (int m = NCTX + gw; m < MTOK; m += NGW) { const int cond = 1 + ((m - NCTX) >> 10);
            u32x2 xw[8], pw[8][4]; f32x4 gf[8];
#pragma unroll
            for (int j = 0; j < 8; ++j) { const int k = 4 * (64 * j + lane); xw[j] = *(const u32x2*)(xr + (size_t)m * D_MODEL + k); gf[j] = *(const f32x4*)(gfl + (size_t)cond * 12288 + k);
#pragma unroll
                for (int q = 0; q < 4; ++q) pw[j][q] = *(const u32x2*)(part + ((size_t)q * NLAT + (m - NCTX)) * D_MODEL + k); }
#pragma unroll
            for (int j = 0; j < 8; ++j) { const int k = 4 * (64 * j + lane); const f32x4 v = (f32x4){bf_lo(xw[j].x), bf_hi(xw[j].x), bf_lo(xw[j].y), bf_hi(xw[j].y)}; f32x4 ps = (f32x4){0.f, 0.f, 0.f, 0.f};
#pragma unroll
                for (int q = 0; q < 4; ++q) ps += (f32x4){bf_lo(pw[j][q].x), bf_hi(pw[j][q].x), bf_lo(pw[j][q].y), bf_hi(pw[j][q].y)};
                *(f32x4*)(args.out + O_Y + (size_t)m * D_MODEL + k) = v + gf[j] * ps; } }
    } PHASE_END
#undef LAYER_BODY
#undef tid
#undef lane
#undef wave
#undef PHASE_BEGIN
#undef PHASE_END
}

extern "C" void kernel_launch(void* const* d_in, const int* in_sizes, int n_in, void* d_out, int out_size, void* d_ws, size_t ws_size, hipStream_t stream) {
    static int grid = 0;
    if (grid == 0) {
        if (n_in != 34 || ws_size < WS_END) { fprintf(stderr, "kernel_launch: unexpected problem (n_in %d, ws %zu)\n", n_in, ws_size); grid = -1; return; }
        int dev = 0, cus = 0, per_cu = 0;
        if (hipGetDevice(&dev) != hipSuccess || hipDeviceGetAttribute(&cus, hipDeviceAttributeMultiprocessorCount, dev) != hipSuccess) { grid = -1; return; }
        if (hipFuncSetAttribute((const void*)trunk_fwd, hipFuncAttributeMaxDynamicSharedMemorySize, LDS_BYTES) != hipSuccess) { fprintf(stderr, "kernel_launch: hipFuncSetAttribute failed\n"); grid = -1; return; }
        if (hipOccupancyMaxActiveBlocksPerMultiprocessor(&per_cu, (const void*)trunk_fwd, 512, LDS_BYTES) != hipSuccess || per_cu < 1) fprintf(stderr, "kernel_launch: occupancy query says %d blocks per CU\n", per_cu);
        (void)hipGetLastError();
        grid = cus < 256 ? cus : 256;
    }
    if (grid < 0) return;
    (void)hipMemsetAsync((char*)d_ws + WS_CTL, 0, CTL_ZERO_BYTES, stream);
    Args a{};
    for (int i = 0; i < 34; ++i) a.in[i] = (const float*)d_in[i];
    a.out = (float*)d_out; a.ws = (unsigned char*)d_ws; a.ph_lo = 0; a.ph_hi = 15;
    hipLaunchKernelGGL(trunk_fwd, dim3(grid), dim3(512), LDS_BYTES, stream, a);
}
```

```cpp
#include <hip/hip_runtime.h>
#include <cstdio>
#include <cstdint>

#define LAS __attribute__((address_space(3)))
typedef unsigned short bf16_t;
typedef short bf16x8 __attribute__((ext_vector_type(8)));
typedef float f32x4 __attribute__((ext_vector_type(4)));
typedef float f32x2 __attribute__((ext_vector_type(2)));
typedef unsigned u32x4 __attribute__((ext_vector_type(4)));
typedef unsigned u32x2 __attribute__((ext_vector_type(2)));

constexpr int D_MODEL = 2048, NCTX = 8192, NLAT = 2048, MTOK = NCTX + NLAT;
constexpr int IN_EVEN = 7200, IN_EVEN_PAD = 7424, IN_ODD = 5120, D_FF = 5632, D_FF2 = 11264;
constexpr float EPS = 1e-6f;
constexpr float LAM_INIT1 = 0.35550906759f;

constexpr size_t MiB = 1u << 20;
constexpr size_t WS_CTL = 0, CTL_ZERO_BYTES = 1 * MiB + 600 * 1024;
constexpr size_t WS_ROWSS = 512 * 1024;
constexpr size_t WS_MOD = 1 * MiB;
constexpr size_t WS_RSF = 600 * 1024;
constexpr size_t WS_BIAS = 1 * MiB + 320 * 1024;
constexpr size_t WS_ROPE = 1 * MiB + 640 * 1024;
constexpr size_t WS_WINE = 2 * MiB;
constexpr size_t WS_WINO = 31 * MiB;
constexpr size_t WS_WOUT = 51 * MiB;
constexpr size_t WS_WUP = 67 * MiB;
constexpr size_t WS_WDN = 155 * MiB;
constexpr size_t WS_XRES = 199 * MiB;
constexpr size_t WS_H = 279 * MiB;
constexpr size_t WS_BIG = 319 * MiB;
constexpr size_t WS_PART = 319 * MiB;
constexpr size_t WS_PROJ = 319 * MiB;
constexpr size_t WS_MIX = 464 * MiB;
constexpr size_t WS_GATES = 504 * MiB;
constexpr size_t WS_ERAW = 506 * MiB;
constexpr size_t WS_ECV = 508 * MiB;
constexpr size_t WS_ACT = 539 * MiB;
constexpr size_t WS_HF = 539 * MiB;
constexpr size_t WS_HB = 579 * MiB;
constexpr size_t WS_END = 649 * MiB;
constexpr int CW_Q0 = 64, CW_Q1 = 128;
constexpr int CW_FIX = 1024;
constexpr int CW_BAR = 4096;

constexpr size_t O_Y = 0, O_NAK = 20971520, O_NAV = 29360128, O_MC = 37748736, O_MN = 46137344, O_MM = 46202880, O_DK = 46203392, O_DV = 54592000;

#ifndef DEFER_PROLOGUE
#define DEFER_PROLOGUE 1
#endif
constexpr int LDS_MISC = 151552;
constexpr int LDS_BYTES = 152576;

__device__ __forceinline__ unsigned cvt_pk_bf16(float lo, float hi) { unsigned r; asm volatile("v_cvt_pk_bf16_f32 %0, %1, %2" : "=v"(r) : "v"(lo), "v"(hi)); return r; }
__device__ __forceinline__ unsigned f2bf(float f) { return cvt_pk_bf16(f, 0.f) & 0xffffu; }
__device__ __forceinline__ float bf_lo(unsigned w) { return __uint_as_float(w << 16); }
__device__ __forceinline__ float bf_hi(unsigned w) { return __uint_as_float(w & 0xffff0000u); }
__device__ __forceinline__ void unpack8(const u32x4 w, float* f) { f[0] = bf_lo(w.x); f[1] = bf_hi(w.x); f[2] = bf_lo(w.y); f[3] = bf_hi(w.y); f[4] = bf_lo(w.z); f[5] = bf_hi(w.z); f[6] = bf_lo(w.w); f[7] = bf_hi(w.w); }
__device__ __forceinline__ u32x4 pack8(const float* f) { u32x4 w; w.x = cvt_pk_bf16(f[0], f[1]); w.y = cvt_pk_bf16(f[2], f[3]); w.z = cvt_pk_bf16(f[4], f[5]); w.w = cvt_pk_bf16(f[6], f[7]); return w; }
__device__ __forceinline__ void load8_bf(const bf16_t* p, float* f) { unpack8(*(const u32x4*)p, f); }
__device__ __forceinline__ void load8_f32(const float* p, float* f) { const f32x4 a = *(const f32x4*)p, b = *(const f32x4*)(p + 4); f[0] = a.x; f[1] = a.y; f[2] = a.z; f[3] = a.w; f[4] = b.x; f[5] = b.y; f[6] = b.z; f[7] = b.w; }
__device__ __forceinline__ void store8_f32(float* p, const float* f) { *(f32x4*)p = (f32x4){f[0], f[1], f[2], f[3]}; *(f32x4*)(p + 4) = (f32x4){f[4], f[5], f[6], f[7]}; }
__device__ __forceinline__ float wave_sum(float v) {
#pragma unroll
    for (int o = 1; o < 64; o <<= 1) v += __shfl_xor(v, o);
    return v;
}
__device__ __forceinline__ float gelu_tanh(float x) { const float y = 0.7978845608f * (x + 0.044715f * x * x * x); return x * __builtin_amdgcn_rcpf(1.f + __expf(-2.f * y)); }
__device__ __forceinline__ float sigmoidf_(float x) { return __builtin_amdgcn_rcpf(1.f + __expf(-x)); }
__device__ __forceinline__ float logsigmoid_(float x) { return x >= 0.f ? -log1pf(__expf(-x)) : x - log1pf(__expf(x)); }
__device__ __forceinline__ bf16x8 as_bf16x8(u32x4 w) { return __builtin_bit_cast(bf16x8, w); }
typedef short v4i16_t __attribute__((ext_vector_type(4)));
__device__ __forceinline__ u32x2 lds_tr(const LAS unsigned char* p) { return __builtin_bit_cast(u32x2, __builtin_amdgcn_ds_read_tr16_b64_v4i16((LAS v4i16_t*)p)); }
#define MFMA16(a, b, c) __builtin_amdgcn_mfma_f32_16x16x32_bf16((a), (b), (c), 0, 0, 0)
#define LDS_WAIT() asm volatile("s_waitcnt lgkmcnt(0)" ::: "memory")
#define VM_WAIT() asm volatile("s_waitcnt vmcnt(0)" ::: "memory")

#ifndef EPI_REP
#define EPI_REP 1
#endif
__device__ __forceinline__ void conv_fixup(const float* eraw, const float* ecv, const float* cw, unsigned short* act, unsigned* cnt, int tid, int G);
namespace pg8 {
constexpr int BM = 256, BK = 64, HALF = 128, HTB = HALF * BK * 2, STAGE_BYTES = 8 * HTB, NXCD = 8, WGM = 8;
__host__ __device__ __forceinline__ int lds_byte(int r, int c) { const int st = (r >> 4) * 2 + (c >> 5), rr = r & 15, cc = c & 31, ob = rr * 64 + cc * 2; return st * 1024 + (ob ^ (((ob >> 9) & 1) << 5)); }
__host__ __device__ __forceinline__ void stage_rc(int b, int& R, int& C) { const int st = b / 1024, sb = b % 1024, swz = sb ^ (((sb >> 9) & 1) << 5); R = (st >> 1) * 16 + swz / 64; C = (st & 1) * 32 + (swz % 64) / 2; }
__host__ __device__ __forceinline__ int perm32(int rho) { const int n = rho >> 4, i = rho & 15; return 8 * (i >> 2) + 4 * n + (i & 3); }
struct Unit { int pm, pn, kt0, nt; };
struct Gemm { const bf16_t* A; const bf16_t* Bt; int M, N, K; };
struct StaticOrder {
    static constexpr bool SPLITK = false;
    int nM, nN, nwg, G, c;
    __host__ __device__ void init(int M, int N, int G_, int c_) { nM = M / BM; nN = N / BM; nwg = nM * nN; G = G_; c = c_; }
    __host__ __device__ bool next(int i, Unit& u) const {
        const long L = (long)i * G + c; if (L >= nwg) return false;
        int wgid = (int)L; { const int q = nwg / NXCD, r = nwg % NXCD, xcd = wgid % NXCD, off = wgid / NXCD; wgid = (xcd < r ? xcd * (q + 1) : r * (q + 1) + (xcd - r) * q) + off; }
        const int nig = WGM * nN, gid = wgid / nig, fm = gid * WGM, gsz = (nM - fm) < WGM ? (nM - fm) : WGM;
        u.pm = fm + ((wgid % nig) % gsz); u.pn = (wgid % nig) / gsz; return true;
    }
    __device__ __forceinline__ void a_ready(const Unit&) const {}
    __device__ __forceinline__ void first_loads_issued() const {}
    __device__ __forceinline__ void done(const Unit&) const {}
};

struct SplitOrder {
    static constexpr bool SPLITK = true;
    int G, c, ntk; unsigned* fix; mutable int seen; const float* fx_eraw; const float* fx_ecv; const float* fx_cw; unsigned short* fx_act;
    __host__ __device__ void init(int K, int G_, int c_, unsigned* fix_) { G = G_; c = c_; ntk = K / BK; fix = fix_; seen = 0; }
    __device__ __forceinline__ void first_loads_issued() const { conv_fixup(fx_eraw, fx_ecv, fx_cw, fx_act, fix, (int)threadIdx.x, G); }
    __host__ __device__ bool next(int i, Unit& u) const {
        const int L = i * G + c; if (L >= 512) return false;
        int v = L & 255; v = (v & 7) * 32 + (v >> 3);
        const bool lat = L >= 256; const int q4 = ntk >> 2;
        u.pm = lat ? 32 + (v & 7) : (v & 7) + 8 * (v >> 6); u.pn = (v >> 3) & 7; u.nt = lat ? q4 : ntk; u.kt0 = lat ? (v >> 6) * q4 : 0;
        return true;
    }
    __device__ __forceinline__ void a_ready(const Unit& u) const {
        if (u.pm >= 32 && !seen) { seen = 1; unsigned sp = 0;
            while (__hip_atomic_load(fix, __ATOMIC_RELAXED, __HIP_MEMORY_SCOPE_AGENT) < (unsigned)G) { __builtin_amdgcn_s_sleep(2); if (++sp > (1u << 22)) break; }
            asm volatile("" ::: "memory"); }
    }
    __device__ __forceinline__ void done(const Unit&) const {}
};
struct EpiStore {
    static constexpr bool PERM = true, AFTER_DRAIN = false, REPEATABLE = false, HAS_PREFETCH = false;
    bf16_t* O; int ldc; float* gates; const float* mlb; int gates_pn;
    int gelu_pn; int ss_pn; float* rowss;
    __device__ __forceinline__ void operator()(const f32x4 (&acc)[2][2][4][2], const Unit& u, int wr, int wc, int fr, int fq) const {
        const int row0 = u.pm * BM + wr * 64 + 4 * fr; const int colt = u.pn * BM;
        if (u.pn >= gelu_pn) {
            const int col0 = colt + wc * 32 + 8 * fq; const bool do_ss = u.pn >= ss_pn;
#pragma unroll
            for (int ai = 0; ai < 2; ++ai)
#pragma unroll
                for (int m = 0; m < 4; ++m) { bf16_t* rowp = O + (size_t)(row0 + ai * HALF + m) * ldc + col0; float ss = 0.f;
#pragma unroll
                    for (int bj = 0; bj < 2; ++bj) { float gv[8];
#pragma unroll
                        for (int j = 0; j < 4; ++j) { gv[j] = gelu_tanh(acc[ai][bj][m][0][j]); gv[4 + j] = gelu_tanh(acc[ai][bj][m][1][j]); }
#pragma unroll
                        for (int j = 0; j < 8; ++j) ss += gv[j] * gv[j];
                        *(u32x4*)(rowp + bj * HALF) = pack8(gv); }
                    if (do_ss) { ss += __shfl_xor(ss, 16); ss += __shfl_xor(ss, 32); if (fq == 0) atomicAdd(rowss + row0 + ai * HALF + m, ss); } }
            return;
        }
        if (gates != nullptr && u.pn == gates_pn) {
            if (wc == 0) {
                const f32x4 b0 = *(const f32x4*)(mlb + 8 * fq), b1 = *(const f32x4*)(mlb + 8 * fq + 4);
#pragma unroll
                for (int ai = 0; ai < 2; ++ai)
#pragma unroll
                    for (int m = 0; m < 4; ++m) { float* rp = gates + (size_t)(row0 + ai * HALF + m) * 32 + 8 * fq;
                        *(f32x4*)rp = acc[ai][0][m][0] + b0; *(f32x4*)(rp + 4) = acc[ai][0][m][1] + b1; }
            }
            return;
        }
        const int col0 = colt + wc * 32 + 8 * fq;
#pragma unroll
        for (int ai = 0; ai < 2; ++ai)
#pragma unroll
            for (int m = 0; m < 4; ++m) { bf16_t* rowp = O + (size_t)(row0 + ai * HALF + m) * ldc + col0;
#pragma unroll
                for (int bj = 0; bj < 2; ++bj) { const f32x4 v0 = acc[ai][bj][m][0], v1 = acc[ai][bj][m][1];
                    u32x4 w; w.x = cvt_pk_bf16(v0[0], v0[1]); w.y = cvt_pk_bf16(v0[2], v0[3]); w.z = cvt_pk_bf16(v1[0], v1[1]); w.w = cvt_pk_bf16(v1[2], v1[3]);
                    *(u32x4*)(rowp + bj * HALF) = w; } }
    }
};
__device__ __forceinline__ float dpp_f(float oldv, float src, const int ctrl_sel) {
    const int o = __builtin_bit_cast(int, oldv), v = __builtin_bit_cast(int, src); int r;
    if (ctrl_sel == 0) r = __builtin_amdgcn_update_dpp(o, v, 0x111, 0xf, 0xf, false);
    else if (ctrl_sel == 1) r = __builtin_amdgcn_update_dpp(o, v, 0x101, 0xf, 0xf, false);
    else if (ctrl_sel == 2) r = __builtin_amdgcn_update_dpp(o, v, 0x10f, 0xf, 0xf, false);
    else r = __builtin_amdgcn_update_dpp(o, v, 0x11f, 0xf, 0xf, false);
    return __builtin_bit_cast(float, r);
}
__device__ __forceinline__ float dpp_z(float src, const int ctrl_sel) {
    const int v = __builtin_bit_cast(int, src); int r;
    if (ctrl_sel == 0) r = __builtin_amdgcn_update_dpp(0, v, 0x111, 0xf, 0xf, true);
    else if (ctrl_sel == 1) r = __builtin_amdgcn_update_dpp(0, v, 0x101, 0xf, 0xf, true);
    else if (ctrl_sel == 2) r = __builtin_amdgcn_update_dpp(0, v, 0x10f, 0xf, 0xf, true);
    else r = __builtin_amdgcn_update_dpp(0, v, 0x11f, 0xf, 0xf, true);
    return __builtin_bit_cast(float, r);
}
__device__ __forceinline__ void fmac_dpp(float& v, float src, float w, const int sel) {
    if (sel == 0) asm("v_fmac_f32_dpp %0, %1, %2 row_shr:1 row_mask:0xf bank_mask:0xf bound_ctrl:1" : "+v"(v) : "v"(src), "v"(w));
    else if (sel == 1) asm("v_fmac_f32_dpp %0, %1, %2 row_shl:1 row_mask:0xf bank_mask:0xf bound_ctrl:1" : "+v"(v) : "v"(src), "v"(w));
    else if (sel == 2) asm("v_fmac_f32_dpp %0, %1, %2 row_shl:15 row_mask:0xf bank_mask:0xf bound_ctrl:1" : "+v"(v) : "v"(src), "v"(w));
    else asm("v_fmac_f32_dpp %0, %1, %2 row_shr:15 row_mask:0xf bank_mask:0xf bound_ctrl:1" : "+v"(v) : "v"(src), "v"(w));
}
struct EpiConv {
    static constexpr bool PERM = true, AFTER_DRAIN = false, REPEATABLE = false, HAS_PREFETCH = true;
    float* eraw; float* ecv; bf16_t* act; const float* cw; const float* cb; LAS float* edge;
    const float* rowss; const float* bias;
    LAS float* cst;
    __device__ __forceinline__ void prefetch(const Unit& u, int par) const {
        const int w = __builtin_amdgcn_readfirstlane((int)(threadIdx.x >> 6)), l = threadIdx.x & 63;
        if (w < 6) {
            const int cond = u.pm < 32 ? 0 : 1 + ((u.pm - 32) >> 2);
            const int co = (l >> 5) * D_FF + u.pn * 128 + (l & 31) * 4;
            const float* src = (w < 3) ? cw + (size_t)w * D_FF2 + co : (w == 3) ? cb + co : (w == 4) ? bias + (size_t)cond * D_FF2 + co : rowss + u.pm * 256 + l * 4;
            __builtin_amdgcn_global_load_lds((const unsigned*)src, (LAS unsigned*)(cst + par * 1536 + w * 256), 16, 0, 0);
        }
    }
    __device__ __forceinline__ void operator()(const f32x4 (&acc_in)[2][2][4][2], const Unit& u, int wr, int wc, int fr, int fq, int par) const {
        const int row0 = u.pm * BM + wr * 64 + 4 * fr;
        f32x4 (&acc)[2][2][4][2] = const_cast<f32x4 (&)[2][2][4][2]>(acc_in);
        const LAS float* cs = cst + par * 1536;
        int c0 = wc * 32 + 8 * fq;
        asm volatile("" : "+v"(c0));
        {
            f32x4 bb[2][2];
#pragma unroll
            for (int bj = 0; bj < 2; ++bj)
#pragma unroll
                for (int n = 0; n < 2; ++n) bb[bj][n] = *(const LAS f32x4*)(cs + 4 * 256 + bj * 128 + c0 + 4 * n);
            const LAS float* rsp = cs + 5 * 256 + wr * 64 + (c0 * 0) + 4 * fr;
#pragma unroll
            for (int ai = 0; ai < 2; ++ai)
#pragma unroll
                for (int m = 0; m < 4; ++m) { const float rs = rsqrtf(rsp[ai * HALF + m] * (1.f / D_MODEL) + EPS);
#pragma unroll
                    for (int bj = 0; bj < 2; ++bj)
#pragma unroll
                        for (int n = 0; n < 2; ++n) acc[ai][bj][m][n] = acc[ai][bj][m][n] * rs + bb[bj][n]; }
        }
        const bool lat = u.pm >= 32;
        const size_t eo_g = ((size_t)((u.pm - 32) * 2 + wr) * 44 + u.pn) * 256 + c0;
        if (fr == 0) {
#pragma unroll
            for (int ai = 0; ai < 2; ++ai)
#pragma unroll
                for (int bj = 0; bj < 2; ++bj)
#pragma unroll
                    for (int n = 0; n < 2; ++n) *(LAS f32x4*)(edge + (((ai * 2 + wr) * 2 + 0) * 256 + bj * 128 + c0 + 4 * n)) = acc[ai][bj][0][n];
            if (lat && wr == 0) {
#pragma unroll
                for (int bj = 0; bj < 2; ++bj)
#pragma unroll
                    for (int n = 0; n < 2; ++n) *(f32x4*)(eraw + eo_g + bj * 128 + 4 * n) = acc[0][bj][0][n];
            }
        }
        if (fr == 15) {
#pragma unroll
            for (int ai = 0; ai < 2; ++ai)
#pragma unroll
                for (int bj = 0; bj < 2; ++bj)
#pragma unroll
                    for (int n = 0; n < 2; ++n) *(LAS f32x4*)(edge + (((ai * 2 + wr) * 2 + 1) * 256 + bj * 128 + c0 + 4 * n)) = acc[ai][bj][3][n];
            if (lat && wr == 1) {
#pragma unroll
                for (int bj = 0; bj < 2; ++bj)
#pragma unroll
                    for (int n = 0; n < 2; ++n) *(f32x4*)(eraw + eo_g + bj * 128 + 4 * n) = acc[1][bj][3][n];
            }
        }
        asm volatile("s_waitcnt lgkmcnt(0)" ::: "memory"); __builtin_amdgcn_s_barrier(); asm volatile("" ::: "memory");
        __builtin_amdgcn_sched_barrier(0);
        const int ncol = u.pn * 128 + c0;
        u32x2 held[2][4];
#pragma unroll
        for (int n = 0; n < 2; ++n) {
            f32x4 wg[3], wv[3];
#pragma unroll
            for (int t = 0; t < 3; ++t) { wg[t] = *(const LAS f32x4*)(cs + t * 256 + c0 + 4 * n); wv[t] = *(const LAS f32x4*)(cs + t * 256 + 128 + c0 + 4 * n); }
            const f32x4 bg = *(const LAS f32x4*)(cs + 3 * 256 + c0 + 4 * n), bv = *(const LAS f32x4*)(cs + 3 * 256 + 128 + c0 + 4 * n);
#pragma unroll
            for (int ai = 0; ai < 2; ++ai) {
#pragma unroll
                for (int m = 0; m < 4; ++m) {
                    f32x4 pe[2] = {(f32x4){0.f, 0.f, 0.f, 0.f}, (f32x4){0.f, 0.f, 0.f, 0.f}}, ne[2] = {(f32x4){0.f, 0.f, 0.f, 0.f}, (f32x4){0.f, 0.f, 0.f, 0.f}};
                    if (m == 0) {
#pragma unroll
                        for (int bj = 0; bj < 2; ++bj) { const int eo = bj * 128 + c0 + 4 * n;
                            if (wr == 1) pe[bj] = *(const LAS f32x4*)(edge + (((ai * 2 + 0) * 2 + 1) * 256 + eo));
                            else if (ai == 1) pe[bj] = *(const LAS f32x4*)(edge + (((0 * 2 + 1) * 2 + 1) * 256 + eo)); }
                    }
                    if (m == 3) {
#pragma unroll
                        for (int bj = 0; bj < 2; ++bj) { const int eo = bj * 128 + c0 + 4 * n;
                            if (wr == 0) ne[bj] = *(const LAS f32x4*)(edge + (((ai * 2 + 1) * 2 + 0) * 256 + eo));
                            else if (ai == 0) ne[bj] = *(const LAS f32x4*)(edge + (((1 * 2 + 0) * 2 + 0) * 256 + eo)); }
                    }
                    f32x4 cvg, cvv;
#pragma unroll
                    for (int bj = 0; bj < 2; ++bj) {
                        const f32x4 cur = acc[ai][bj][m][n]; const f32x4* w = bj ? wv : wg;
                        f32x4 v = w[1] * cur + (bj ? bv : bg);
                        if (m > 0) v = w[0] * acc[ai][bj][m > 0 ? m - 1 : 0][n] + v;
                        else {
#pragma unroll
                            for (int j = 0; j < 4; ++j) { float t_ = v[j]; fmac_dpp(t_, acc[ai][bj][3][n][j], w[0][j], 0); v[j] = t_; }
                            const f32x4 pz = (fr == 0) ? pe[bj] : (f32x4){0.f, 0.f, 0.f, 0.f}; v = w[0] * pz + v; }
                        if (m < 3) v = w[2] * acc[ai][bj][m < 3 ? m + 1 : 3][n] + v;
                        else {
#pragma unroll
                            for (int j = 0; j < 4; ++j) { float t_ = v[j]; fmac_dpp(t_, acc[ai][bj][0][n][j], w[2][j], 1); v[j] = t_; }
                            const f32x4 nz = (fr == 15) ? ne[bj] : (f32x4){0.f, 0.f, 0.f, 0.f}; v = w[2] * nz + v; }
                        if (bj) cvv = v; else cvg = v;
                    }
                    if ((ai == 0 && m == 0) || (ai == 1 && m == 3)) {
                        if (lat && wr == ai && fr == (ai ? 15 : 0)) { float* ep = ecv + eo_g + 4 * n; *(f32x4*)ep = cvg; *(f32x4*)(ep + 128) = cvv; }
                    }
                    f32x4 o;
                    { const f32x4 t = cvg * -1.4426950408889634f; f32x4 e;
#pragma unroll
                      for (int j = 0; j < 4; ++j) e[j] = __builtin_amdgcn_exp2f(t[j]);
                      e = e + 1.f;
#pragma unroll
                      for (int j = 0; j < 4; ++j) e[j] = __builtin_amdgcn_rcpf(e[j]);
                      o = (cvg * cvv) * e; }
                    u32x2 w2; w2.x = cvt_pk_bf16(o[0], o[1]); w2.y = cvt_pk_bf16(o[2], o[3]);
                    if (n == 0) held[ai][m] = w2;
                    else *(u32x4*)(act + (size_t)(row0 + ai * HALF + m) * D_FF + ncol) = (u32x4){held[ai][m].x, held[ai][m].y, w2.x, w2.y};
                }
            }
        }
    }
};
template <bool RB, bool OB, bool PF = false>
struct EpiRes {
    static constexpr bool PERM = true, AFTER_DRAIN = false, REPEATABLE = false, HAS_PREFETCH = false;
    const void* res0; const void* res1; void* outp; const float* gvec; bf16_t* part;
    bf16_t* hA; const float* gnorm; const float* nscale; float* rowss;
    __device__ __forceinline__ void operator()(const f32x4 (&acc)[2][2][4][2], const Unit& u, int wr, int wc, int fr, int fq) const {
        const int row0 = u.pm * BM + wr * 64 + 4 * fr; const int colt = u.pn * BM;
        if (part != nullptr && u.pm >= 32) {
            bf16_t* pb = part + ((size_t)(u.kt0 / u.nt) * NLAT + (row0 - NCTX)) * D_MODEL + colt + wc * 32 + 8 * fq;
#pragma unroll
            for (int ai = 0; ai < 2; ++ai)
#pragma unroll
                for (int m = 0; m < 4; ++m)
#pragma unroll
                    for (int bj = 0; bj < 2; ++bj) { const f32x4 v0 = acc[ai][bj][m][0], v1 = acc[ai][bj][m][1];
                        u32x4 w; w.x = cvt_pk_bf16(v0[0], v0[1]); w.y = cvt_pk_bf16(v0[2], v0[3]); w.z = cvt_pk_bf16(v1[0], v1[1]); w.w = cvt_pk_bf16(v1[2], v1[3]);
                        *(u32x4*)(pb + (size_t)(ai * HALF + m) * D_MODEL + bj * HALF) = w; }
            return;
        }
        const int cond = u.pm < 32 ? 0 : 1 + ((u.pm - 32) >> 2);
        const int col0 = colt + wc * 32 + 8 * fq;
        const float* gv = gvec + (size_t)cond * 12288 + col0;
        f32x4 g[2][2];
#pragma unroll
        for (int bj = 0; bj < 2; ++bj)
#pragma unroll
            for (int n = 0; n < 2; ++n) g[bj][n] = *(const f32x4*)(gv + bj * HALF + 4 * n);
        f32x4 gn[2][2];
        if (hA != nullptr) {
#pragma unroll
            for (int bj = 0; bj < 2; ++bj)
#pragma unroll
                for (int n = 0; n < 2; ++n) gn[bj][n] = *(const f32x4*)(gnorm + col0 + bj * HALF + 4 * n) * (*(const f32x4*)(nscale + (size_t)cond * 12288 + col0 + bj * HALF + 4 * n) + 1.f);
        }
        const size_t rrow = (u.pm < 32) ? (size_t)row0 : (size_t)(row0 - NCTX);
        const char* rbase = (const char*)(u.pm < 32 ? res0 : res1) + (rrow * D_MODEL + col0) * (RB ? 2 : 4);
        char* obase = (char*)outp + ((size_t)row0 * D_MODEL + col0) * (OB ? 2 : 4);
        u32x4 rrb[2][2][2][2]; f32x4 rrf[2][2][2][2];
        if (RB && PF) {
#pragma unroll
            for (int ai = 0; ai < 2; ++ai)
#pragma unroll
                for (int mh = 0; mh < 2; ++mh)
#pragma unroll
                    for (int m2 = 0; m2 < 2; ++m2)
#pragma unroll
                        for (int bj = 0; bj < 2; ++bj) rrb[ai][mh][m2][bj] = *(const u32x4*)(rbase + ((size_t)(ai * HALF + (2 * mh + m2)) * D_MODEL + bj * HALF) * 2);
        }
#pragma unroll
        for (int ai = 0; ai < 2; ++ai) {
#pragma unroll
          for (int mh = 0; mh < 2; ++mh) {
            if (!(RB && PF)) {
#pragma unroll
                for (int m2 = 0; m2 < 2; ++m2)
#pragma unroll
                    for (int bj = 0; bj < 2; ++bj) { const size_t eo = (size_t)(ai * HALF + (2 * mh + m2)) * D_MODEL + bj * HALF;
                        if (RB) rrb[ai][mh][m2][bj] = *(const u32x4*)(rbase + eo * 2);
                        else { rrf[mh][m2][bj][0] = *(const f32x4*)(rbase + eo * 4); rrf[mh][m2][bj][1] = *(const f32x4*)(rbase + eo * 4 + 16); } }
            }
#pragma unroll
            for (int m2 = 0; m2 < 2; ++m2) { const int m = 2 * mh + m2; float ss = 0.f;
#pragma unroll
                for (int bj = 0; bj < 2; ++bj) { const size_t eo = (size_t)(ai * HALF + m) * D_MODEL + bj * HALF;
                    f32x4 r0, r1;
                    if (RB) { float f8[8]; unpack8(rrb[ai][mh][m2][bj], f8); r0 = (f32x4){f8[0], f8[1], f8[2], f8[3]}; r1 = (f32x4){f8[4], f8[5], f8[6], f8[7]}; }
                    else { r0 = rrf[mh][m2][bj][0]; r1 = rrf[mh][m2][bj][1]; }
                    const f32x4 v0 = r0 + g[bj][0] * acc[ai][bj][m][0], v1 = r1 + g[bj][1] * acc[ai][bj][m][1];
                    if (OB) { u32x4 w; w.x = cvt_pk_bf16(v0[0], v0[1]); w.y = cvt_pk_bf16(v0[2], v0[3]); w.z = cvt_pk_bf16(v1[0], v1[1]); w.w = cvt_pk_bf16(v1[2], v1[3]); *(u32x4*)(obase + eo * 2) = w; }
                    else { *(f32x4*)(obase + eo * 4) = v0; *(f32x4*)(obase + eo * 4 + 16) = v1; }
                    if (hA != nullptr) { const f32x4 h0 = v0 * gn[bj][0], h1 = v1 * gn[bj][1];
                        u32x4 w; w.x = cvt_pk_bf16(h0[0], h0[1]); w.y = cvt_pk_bf16(h0[2], h0[3]); w.z = cvt_pk_bf16(h1[0], h1[1]); w.w = cvt_pk_bf16(h1[2], h1[3]);
                        *(u32x4*)(hA + (size_t)(row0 + ai * HALF + m) * D_MODEL + col0 + bj * HALF) = w;
                        ss += (v0[0] * v0[0] + v0[1] * v0[1]) + (v0[2] * v0[2] + v0[3] * v0[3]) + (v1[0] * v1[0] + v1[1] * v1[1]) + (v1[2] * v1[2] + v1[3] * v1[3]); } }
                if (hA != nullptr) { ss += __shfl_xor(ss, 16); ss += __shfl_xor(ss, 32); if (fq == 0) atomicAdd(rowss + row0 + ai * HALF + m, ss); } }
            asm volatile("" ::: "memory");
          }
        }
    }
};

template <class Epi, class Sched, bool ALIGN_EPI = false, bool SP2 = false>
__device__ __forceinline__ void gemm_phase(LAS unsigned char* lds, const Gemm g, const Sched& S, const Epi& E) {
    const int tid = threadIdx.x, wid = __builtin_amdgcn_readfirstlane(tid >> 6), lane = tid & 63, wr = wid >> 2, wc = wid & 3, fr = lane & 15, fq = lane >> 4;
    const int K = g.K, nt = K / BK;
    unsigned voffA[2], voffB[2];
#pragma unroll
    for (int i = 0; i < 2; ++i) { int R, C; stage_rc(tid * 16 + i * 8192, R, C); const int Rb = Epi::PERM ? ((R & ~31) + perm32(R & 31)) : R;
        const int Ra = Epi::PERM ? ((R & ~63) + 4 * (R & 15) + ((R >> 4) & 3)) : R;
        voffA[i] = (unsigned)(Ra * K + C) * 2u; voffB[i] = (unsigned)(Rb * K + C) * 2u; }
    const size_t kstep = (size_t)(BK * 2);
    const size_t hstep = (size_t)HALF * K * 2;
    const size_t tstep = 2 * hstep;
    const unsigned ldsw = (unsigned)wid * 1024u;
    const int aoff = lds_byte(wr * 64 + fr, fq * 8), boff = lds_byte(wc * 32 + fr, fq * 8);
#define PG8_SA(b, h) (((b) * 2 + (h)) * HTB)
#define PG8_SB(b, h) ((4 + (b) * 2 + (h)) * HTB)
#define PG8_STAGE(bufoff, gbase, voff) do { _Pragma("unroll") for (int _i = 0; _i < 2; ++_i) \
        __builtin_amdgcn_global_load_lds((const unsigned*)((const char*)(gbase) + (voff)[_i]), (LAS unsigned*)(lds + (bufoff) + ldsw + _i * 8192), 16, 0, 0); } while (0)
#define PG8_LDA(dst, b, h) do { _Pragma("unroll") for (int m = 0; m < 4; ++m) _Pragma("unroll") for (int k = 0; k < 2; ++k) dst[m][k] = *(const LAS bf16x8*)(lds + PG8_SA(b, h) + aoff + m * 2048 + k * 1024); } while (0)
#define PG8_LDB(dst, b, h) do { _Pragma("unroll") for (int n = 0; n < 2; ++n) _Pragma("unroll") for (int k = 0; k < 2; ++k) dst[n][k] = *(const LAS bf16x8*)(lds + PG8_SB(b, h) + boff + n * 2048 + k * 1024); } while (0)
#define PG8_MMA(ai, bj, At, Bt) do { __builtin_amdgcn_s_setprio(1); _Pragma("unroll") for (int m = 0; m < 4; ++m) _Pragma("unroll") for (int n = 0; n < 2; ++n) _Pragma("unroll") for (int k = 0; k < 2; ++k) \
        acc[ai][bj][m][n] = __builtin_amdgcn_mfma_f32_16x16x32_bf16(Bt[n][k], At[m][k], acc[ai][bj][m][n], 0, 0, 0); __builtin_amdgcn_s_setprio(0); } while (0)
#define PG8_WAIT_V(n) asm volatile("s_waitcnt vmcnt(" #n ")" ::: "memory")
#define PG8_WAIT_L(n) asm volatile("s_waitcnt lgkmcnt(" #n ")" ::: "memory")
#define PG8_BAR __builtin_amdgcn_s_barrier()
#define PG8_SCHED __builtin_amdgcn_sched_barrier(0)
    Unit cur, nxt; int ui = 0;
    if (!S.next(0, cur)) return;
    f32x4 acc[2][2][4][2];
#pragma unroll
    for (int a = 0; a < 2; ++a)
#pragma unroll
        for (int b = 0; b < 2; ++b)
#pragma unroll
            for (int m = 0; m < 4; ++m)
#pragma unroll
                for (int n = 0; n < 2; ++n) acc[a][b][m][n] = (f32x4){0.f, 0.f, 0.f, 0.f};
    bf16x8 At[4][2], B0[2][2], B1[2][2];
    int cnt = nt;
    const char* cA = (const char*)g.A + (size_t)cur.pm * tstep; const char* cB = (const char*)g.Bt + (size_t)cur.pn * tstep;
    if constexpr (Sched::SPLITK) { cnt = cur.nt; cA += (size_t)cur.kt0 * kstep; cB += (size_t)cur.kt0 * kstep; }
    S.a_ready(cur);
    if constexpr (Epi::HAS_PREFETCH) E.prefetch(cur, 0);
    if constexpr (SP2) {
        PG8_STAGE(PG8_SB(0, 0), cB, voffB); PG8_STAGE(PG8_SB(0, 1), cB + hstep, voffB); PG8_STAGE(PG8_SA(0, 0), cA, voffA); PG8_STAGE(PG8_SA(0, 1), cA + hstep, voffA);
        S.first_loads_issued();
        if (wr == 1) PG8_BAR;
        PG8_WAIT_V(2); PG8_BAR;
        PG8_STAGE(PG8_SB(1, 0), cB + kstep, voffB); PG8_STAGE(PG8_SA(1, 0), cA + kstep, voffA); PG8_STAGE(PG8_SB(1, 1), cB + hstep + kstep, voffB);
        PG8_WAIT_V(6); PG8_BAR;
    } else {
        PG8_STAGE(PG8_SB(0, 0), cB, voffB); PG8_STAGE(PG8_SA(0, 0), cA, voffA); PG8_STAGE(PG8_SB(0, 1), cB + hstep, voffB); PG8_STAGE(PG8_SA(0, 1), cA + hstep, voffA);
        if (wr == 1) PG8_BAR;
        PG8_WAIT_V(4); PG8_BAR;
        PG8_STAGE(PG8_SB(1, 0), cB + kstep, voffB); PG8_STAGE(PG8_SA(1, 0), cA + kstep, voffA); PG8_STAGE(PG8_SB(1, 1), cB + hstep + kstep, voffB);
        PG8_WAIT_V(6); PG8_BAR;
    }
    for (;;) {
        const bool has_next = S.next(ui + 1, nxt);
        const char* nA = has_next ? (const char*)g.A + (size_t)nxt.pm * tstep : cA; const char* nB = has_next ? (const char*)g.Bt + (size_t)nxt.pn * tstep : cB;
        if constexpr (Sched::SPLITK) { if (has_next) { nA += (size_t)nxt.kt0 * kstep; nB += (size_t)nxt.kt0 * kstep; } }
        for (int t = 0; t < cnt; t += 2) {
            const bool last = (t == cnt - 2);
            const char* a1 = cA + (size_t)(t + 1) * kstep;
            const char* a2 = last ? nA : cA + (size_t)(t + 2) * kstep; const char* b2 = last ? nB : cB + (size_t)(t + 2) * kstep;
            const char* a3 = a2 + kstep; const char* b3 = b2 + kstep;
            if (last && has_next) S.a_ready(nxt);
            if constexpr (SP2) {
            PG8_LDB(B0, 0, 0); PG8_LDB(B1, 0, 1); PG8_SCHED; PG8_LDA(At, 0, 0); PG8_STAGE(PG8_SA(1, 1), a1 + hstep, voffA);
            PG8_WAIT_V(8); PG8_WAIT_L(0); PG8_BAR; PG8_MMA(0, 0, At, B0); PG8_MMA(0, 1, At, B1); PG8_BAR; PG8_SCHED;
            PG8_LDA(At, 0, 1); PG8_STAGE(PG8_SB(0, 0), b2, voffB); PG8_STAGE(PG8_SB(0, 1), b2 + hstep, voffB); PG8_STAGE(PG8_SA(0, 0), a2, voffA);
            PG8_WAIT_V(8); PG8_WAIT_L(0); PG8_BAR; PG8_MMA(1, 0, At, B0); PG8_MMA(1, 1, At, B1); PG8_BAR; PG8_SCHED;
            PG8_LDB(B0, 1, 0); PG8_LDB(B1, 1, 1); PG8_SCHED; PG8_LDA(At, 1, 0); PG8_STAGE(PG8_SA(0, 1), a2 + hstep, voffA);
            PG8_WAIT_V(8); PG8_WAIT_L(0); PG8_BAR; PG8_MMA(0, 0, At, B0); PG8_MMA(0, 1, At, B1); PG8_BAR; PG8_SCHED;
            PG8_LDA(At, 1, 1); PG8_STAGE(PG8_SB(1, 0), b3, voffB); PG8_STAGE(PG8_SB(1, 1), b3 + hstep, voffB); PG8_STAGE(PG8_SA(1, 0), a3, voffA);
            PG8_WAIT_V(8); PG8_WAIT_L(0); PG8_BAR; PG8_MMA(1, 0, At, B0); PG8_MMA(1, 1, At, B1); PG8_BAR; PG8_SCHED;
            } else {
            PG8_LDB(B0, 0, 0); PG8_SCHED; PG8_LDA(At, 0, 0); PG8_STAGE(PG8_SA(1, 1), a1 + hstep, voffA);
            PG8_WAIT_L(8); PG8_BAR; PG8_WAIT_L(0); PG8_MMA(0, 0, At, B0); PG8_BAR; PG8_SCHED;
            PG8_LDB(B1, 0, 1); PG8_STAGE(PG8_SB(0, 0), b2, voffB);
            PG8_BAR; PG8_WAIT_L(0); PG8_MMA(0, 1, At, B1); PG8_BAR;
            PG8_LDA(At, 0, 1); PG8_STAGE(PG8_SA(0, 0), a2, voffA);
            PG8_BAR; PG8_WAIT_L(0); PG8_MMA(1, 0, At, B0); PG8_BAR; PG8_SCHED;
            PG8_STAGE(PG8_SB(0, 1), b2 + hstep, voffB);
            PG8_WAIT_V(6); PG8_BAR; PG8_MMA(1, 1, At, B1); PG8_BAR;
            PG8_LDB(B0, 1, 0); PG8_SCHED; PG8_LDA(At, 1, 0); PG8_STAGE(PG8_SA(0, 1), a2 + hstep, voffA);
            PG8_WAIT_L(8); PG8_BAR; PG8_WAIT_L(0); PG8_MMA(0, 0, At, B0); PG8_BAR; PG8_SCHED;
            PG8_LDB(B1, 1, 1); PG8_STAGE(PG8_SB(1, 0), b3, voffB);
            PG8_BAR; PG8_WAIT_L(0); PG8_MMA(0, 1, At, B1); PG8_BAR;
            PG8_LDA(At, 1, 1); PG8_STAGE(PG8_SA(1, 0), a3, voffA);
            PG8_BAR; PG8_WAIT_L(0); PG8_MMA(1, 0, At, B0); PG8_BAR; PG8_SCHED;
            PG8_STAGE(PG8_SB(1, 1), b3 + hstep, voffB);
            PG8_WAIT_V(6); PG8_BAR; PG8_MMA(1, 1, At, B1); PG8_BAR;
            }
        }
        if constexpr (ALIGN_EPI) { if (wr == 0) PG8_BAR; }
        if constexpr (!Epi::AFTER_DRAIN) { if constexpr (Epi::HAS_PREFETCH) E(acc, cur, wr, wc, fr, fq, ui & 1); else E(acc, cur, wr, wc, fr, fq); S.done(cur); }
        if (!has_next) break;
#pragma unroll
        for (int a = 0; a < 2; ++a)
#pragma unroll
            for (int b = 0; b < 2; ++b)
#pragma unroll
                for (int m = 0; m < 4; ++m)
#pragma unroll
                    for (int n = 0; n < 2; ++n) acc[a][b][m][n] = (f32x4){0.f, 0.f, 0.f, 0.f};
        cur = nxt; cA = nA; cB = nB; ++ui;
        if constexpr (Epi::HAS_PREFETCH) E.prefetch(cur, ui & 1);
        if constexpr (Sched::SPLITK) cnt = cur.nt;
        if constexpr (ALIGN_EPI) { if (wr == 1) PG8_BAR; }
    }
    PG8_WAIT_V(0);
    if constexpr (!ALIGN_EPI) { if (wr == 0) PG8_BAR; }
    PG8_BAR;
#undef PG8_SA
#undef PG8_SB
#undef PG8_STAGE
#undef PG8_LDA
#undef PG8_LDB
#undef PG8_MMA
#undef PG8_WAIT_V
#undef PG8_WAIT_L
#undef PG8_BAR
#undef PG8_SCHED
}
}

#define XB_TMO      128
#define XB_XCNT(j)  (256  + 64 * (j))
#define XB_XSUB(j)  (1280 + 64 * (j))
#define XB_XGEN(j)  (2304 + 64 * (j))
#define XB_TOP      3328
#define XB_TOPGEN   3392
#define XCD_BAR_WORDS 3456
#define XB_SPIN_CAP (1u << 18)
__device__ __forceinline__ unsigned xb_ld(unsigned* p)              { return __hip_atomic_load(p, __ATOMIC_RELAXED, __HIP_MEMORY_SCOPE_AGENT); }
__device__ __forceinline__ unsigned xb_add(unsigned* p, unsigned v) { return __hip_atomic_fetch_add(p, v, __ATOMIC_RELAXED, __HIP_MEMORY_SCOPE_AGENT); }
__device__ __forceinline__ unsigned xb_xcc_id() { return (unsigned)__builtin_amdgcn_s_getreg((3 << 11) | 20) & 0xFu; }
#define XB_SPIN(cond, bar) do { unsigned _sp = 0; while (cond) { __builtin_amdgcn_s_sleep(1); \
    if ((++_sp & 255u) == 0u) { if (xb_ld(&(bar)[XB_TMO])) break; if (_sp > XB_SPIN_CAP) { atomicAdd(&(bar)[XB_TMO], 1u); break; } } } } while (0)
struct XcdBarrier { unsigned* bar; unsigned x; volatile LAS unsigned* st; };
__device__ __forceinline__ XcdBarrier xcd_barrier_post(unsigned* bar, volatile LAS unsigned* st) {
    XcdBarrier b; b.bar = bar; b.x = xb_xcc_id(); b.st = st;
    if (threadIdx.x == 0) (void)xb_add(&bar[XB_XCNT(b.x)], 1u);
    return b;
}
__device__ __forceinline__ void xcd_barrier_complete(unsigned* bar, unsigned x, unsigned& nloc, unsigned& nx) {
    const unsigned G = gridDim.x * gridDim.y * gridDim.z;
    unsigned sum, cnt, mine, sp = 0u;
    for (;;) {
        sum = 0u; cnt = 0u; mine = 0u;
#pragma unroll
        for (unsigned j = 0; j < 16; ++j) { const unsigned c = xb_ld(&bar[XB_XCNT(j)]); sum += c; cnt += (c > 0u) ? 1u : 0u; mine = (j == x) ? c : mine; }
        if (sum == G) break;
        __builtin_amdgcn_s_sleep(1);
        if ((++sp & 255u) == 0u) { if (xb_ld(&bar[XB_TMO])) break; if (sp > XB_SPIN_CAP) { atomicAdd(&bar[XB_TMO], 1u); break; } }
    }
    nloc = mine > 0u ? mine : 1u; nx = cnt > 0u ? cnt : 1u;
}
__device__ __forceinline__ void xcd_barrier(const XcdBarrier& b) {
    asm volatile("s_waitcnt vmcnt(0)" ::: "memory");
    __syncthreads();
    if (threadIdx.x == 0) {
        unsigned* bar = b.bar;
        __builtin_amdgcn_s_waitcnt(0);
        unsigned nloc = b.st[0], nx = b.st[1];
        if (nloc == 0u) { xcd_barrier_complete(bar, b.x, nloc, nx); b.st[0] = nloc; b.st[1] = nx; }
        const unsigned old = xb_add(&bar[XB_XSUB(b.x)], 1u);
        __builtin_amdgcn_fence(__ATOMIC_ACQUIRE, "agent");
        const unsigned gen = old / nloc;
        if (old + 1u == (gen + 1u) * nloc) {
            __builtin_amdgcn_fence(__ATOMIC_RELEASE, "agent");
            asm volatile("s_waitcnt vmcnt(0)" ::: "memory");
            (void)xb_add(&bar[XB_TOP], 1u);
        }
        XB_SPIN(xb_ld(&bar[XB_TOP]) < (gen + 1u) * nx, bar);
        asm volatile("s_waitcnt vmcnt(0)" ::: "memory");
    }
    __syncthreads();
}

struct Args { const float* in[34]; float* out; unsigned char* ws; int ph_lo, ph_hi; };
enum { I_XP = 0, I_XS, I_CNAK, I_CNAV, I_SMC, I_SMN, I_SMM, I_CDK, I_CDV, I_C, I_CCTX, I_WMOD, I_BMOD, I_GMIX, I_GFFN, I_WOUT, I_WINE, I_NAGQ, I_NAGK, I_RPB, I_MLB, I_MLG,
       I_WINO, I_DGQ, I_DGK, I_DLAM, I_DGOUT, I_SGG, I_SGW, I_SGB, I_WUP, I_CONVW, I_CONVB, I_WDN };

__device__ __forceinline__ void p0_transpose_item(const float* W, int K, int N, bf16_t* WT, LAS float* scr, int item, int lane, bool ffn_up = false, const float* bias_sf = nullptr, float* bias_out = nullptr) {
    const int nblk = N / 32, kb = item / nblk, nb = item % nblk, k0 = 64 * kb, n0 = 32 * nb;
    const int d0 = ffn_up ? (n0 < D_FF ? 256 * (n0 >> 7) + (n0 & 127) : 256 * ((n0 - D_FF) >> 7) + 128 + ((n0 - D_FF) & 127)) : n0;
    { f32x4 t[8];
#pragma unroll
      for (int i = 0; i < 8; ++i) t[i] = __builtin_nontemporal_load((const f32x4*)(W + (size_t)(k0 + 8 * i + (lane >> 3)) * N + n0 + 4 * (lane & 7)));
#pragma unroll
      for (int i = 0; i < 8; ++i) { LAS float* d = scr + (8 * i + (lane >> 3)) * 33 + 4 * (lane & 7); d[0] = t[i].x; d[1] = t[i].y; d[2] = t[i].z; d[3] = t[i].w; } }
    LDS_WAIT(); asm volatile("" ::: "memory");
    if (ffn_up) {
        float sb[3] = {0.f, 0.f, 0.f};
        const float* sf = bias_sf + k0 + 32 * (lane >> 5);
#pragma unroll 8
        for (int kk = 0; kk < 32; ++kk) { const float w = scr[(32 * (lane >> 5) + kk) * 33 + (lane & 31)];
#pragma unroll
            for (int r = 0; r < 3; ++r) sb[r] += sf[(size_t)r * 12288 + kk] * w; }
#pragma unroll
        for (int r = 0; r < 3; ++r) { sb[r] += __shfl_xor(sb[r], 32); if (lane < 32) atomicAdd(bias_out + (size_t)r * D_FF2 + n0 + lane, sb[r]); }
    }
    const int c = lane & 7;
#pragma unroll
    for (int j = 0; j < 4; ++j) { const int n = (lane >> 3) + 8 * j; const LAS float* s = scr + (8 * c) * 33 + n;
        u32x4 o; o.x = cvt_pk_bf16(s[0 * 33], s[1 * 33]); o.y = cvt_pk_bf16(s[2 * 33], s[3 * 33]); o.z = cvt_pk_bf16(s[4 * 33], s[5 * 33]); o.w = cvt_pk_bf16(s[6 * 33], s[7 * 33]);
        __builtin_nontemporal_store(o, (u32x4*)(WT + (size_t)(d0 + n) * K + k0 + 8 * c)); }
    LDS_WAIT(); asm volatile("" ::: "memory");
}

__device__ __forceinline__ void gemv_items(const Args& a, LAS unsigned char* lds, int blk_lo, int blk_hi, int widx, int nwork, int tid) {
    LAS float* sc = (LAS float*)lds;
    LAS float* red = (LAS float*)(lds + 4096);
    float* mod = (float*)(a.ws + WS_MOD);
    const int nitems = (blk_hi - blk_lo) * 8;
    for (int it = widx; it < nitems; it += nwork) {
        const int cb = blk_lo + (it >> 3), ks = it & 7, l = cb / 96, j0 = (cb % 96) * 128, k0 = ks * 256;
        __syncthreads();
        for (int i = tid; i < 3 * 256; i += 512) { const int r = i >> 8, k = k0 + (i & 255); const float v = (r == 0) ? a.in[I_CCTX][k] : a.in[I_C][(r - 1) * 2048 + k]; sc[i] = v / (1.f + __expf(-v)); }
        __syncthreads();
        const int cq = tid & 31, kg = tid >> 5;
        float acc[3][4];
#pragma unroll
        for (int r = 0; r < 3; ++r)
#pragma unroll
            for (int e = 0; e < 4; ++e) acc[r][e] = 0.f;
        const float* wp = a.in[I_WMOD] + ((size_t)l * 2048 + k0) * 12288 + j0 + 4 * cq;
#pragma unroll 8
        for (int k = kg; k < 256; k += 16) { const f32x4 w = *(const f32x4*)(wp + (size_t)k * 12288);
#pragma unroll
            for (int r = 0; r < 3; ++r) { const float s_ = sc[r * 256 + k]; acc[r][0] += s_ * w.x; acc[r][1] += s_ * w.y; acc[r][2] += s_ * w.z; acc[r][3] += s_ * w.w; } }
#pragma unroll
        for (int r = 0; r < 3; ++r)
#pragma unroll
            for (int e = 0; e < 4; ++e) red[(kg * 32 + cq) * 12 + r * 4 + e] = acc[r][e];
        __syncthreads();
        if (tid < 384) { const int r = tid >> 7, jj = tid & 127, cq2 = jj >> 2, e = jj & 3; float s_ = 0.f;
#pragma unroll
            for (int kg2 = 0; kg2 < 16; ++kg2) s_ += red[(kg2 * 32 + cq2) * 12 + r * 4 + e];
            if (ks == 0) s_ += a.in[I_BMOD][l * 12288 + j0 + jj];
            atomicAdd(mod + (size_t)(l * 3 + r) * 12288 + j0 + jj, s_); }
    }
    __syncthreads();
}
constexpr int CI_E = 32 * (IN_EVEN / 32), CI_O = 32 * (IN_ODD / 32), CI_W = 32 * 64, CI_U = 32 * (D_FF2 / 32), CI_D = 88 * 64;
constexpr int CV_E = 0, CV_O = CV_E + CI_E, CV_W0 = CV_O + CI_O, CV_W1 = CV_W0 + CI_W, CV_U0 = CV_W1 + CI_W, CV_U1 = CV_U0 + CI_U, CV_D0 = CV_U1 + CI_U, CV_D1 = CV_D0 + CI_D, CV_END = CV_D1 + CI_D;
__device__ __forceinline__ void convert_one(const Args& a, LAS float* scr, int it, int lane) {
    int r = it;
    if (r < CI_E) { p0_transpose_item(a.in[I_WINE], 2048, IN_EVEN, (bf16_t*)(a.ws + WS_WINE), scr, r, lane); return; } r -= CI_E;
    if (r < CI_O) { p0_transpose_item(a.in[I_WINO], 2048, IN_ODD, (bf16_t*)(a.ws + WS_WINO), scr, r, lane); return; } r -= CI_O;
    if (r < 2 * CI_W) { const int l = r / CI_W; p0_transpose_item(a.in[I_WOUT] + (size_t)l * 2048 * 2048, 2048, 2048, (bf16_t*)(a.ws + WS_WOUT) + (size_t)l * 2048 * 2048, scr, r % CI_W, lane); return; } r -= 2 * CI_W;
    if (r < 2 * CI_U) { const int l = r / CI_U; p0_transpose_item(a.in[I_WUP] + (size_t)l * 2048 * D_FF2, 2048, D_FF2, (bf16_t*)(a.ws + WS_WUP) + (size_t)l * 2048 * D_FF2, scr, r % CI_U, lane, true,
            (const float*)(a.ws + WS_MOD) + (size_t)l * 3 * 12288 + 3 * 2048, (float*)(a.ws + WS_BIAS) + (size_t)l * 3 * D_FF2); return; } r -= 2 * CI_U;
    { const int l = r / CI_D; p0_transpose_item(a.in[I_WDN] + (size_t)l * D_FF * 2048, D_FF, 2048, (bf16_t*)(a.ws + WS_WDN) + (size_t)l * D_FF * 2048, scr, r % CI_D, lane); }
}
__device__ __forceinline__ void convert_items(const Args& a, LAS unsigned char* lds, int lo, int hi, int widx, int nwork, int lane, int wave) {
    LAS float* scr = (LAS float*)(lds + wave * 16384);
    for (int it = lo + widx * 8 + wave; it < hi; it += nwork * 8) convert_one(a, scr, it, lane);
}

__device__ __forceinline__ void p0_prologue(const Args& a, LAS unsigned char* lds, int tid, int lane, int wave, int G) {
    if (blockIdx.x == 0) { float* rt = (float*)(a.ws + WS_ROPE);
        for (int i = tid; i < 1024; i += 512) { const int pos = i >> 4, f = i & 15; const float rev = (float)pos * exp2f(-(float)f * 0.8304820237218406f) * 0.15915494309189535f; const float fr_ = rev - floorf(rev);
            rt[2 * i] = __builtin_amdgcn_cosf(fr_); rt[2 * i + 1] = __builtin_amdgcn_sinf(fr_); } }
    gemv_items(a, lds, 0, 32, (int)blockIdx.x, G, tid);
    convert_items(a, lds, CV_E, CV_O, (int)blockIdx.x, G, lane, wave);
    convert_items(a, lds, CV_W0, CV_W1, (int)blockIdx.x, G, lane, wave);
#if !DEFER_PROLOGUE
    gemv_items(a, lds, 32, 192, (int)blockIdx.x, G, tid);
    convert_items(a, lds, CV_O, CV_W0, (int)blockIdx.x, G, lane, wave);
    convert_items(a, lds, CV_W1, CV_END, (int)blockIdx.x, G, lane, wave);
#endif
}

template <bool XB>
__device__ __forceinline__ void norm_phase(const void* x0, const void* x1, const float* g, const float* mod_l, int shift_idx, bf16_t* h, int lane, int wave, int G,
                                           const bf16_t* part = nullptr, const float* pgate = nullptr, bf16_t* xw = nullptr) {
    const int gw = blockIdx.x * 8 + wave, NGW = G * 8;
    for (int m = gw; m < MTOK; m += NGW) {
        const char* xr = (const char*)((m < NCTX) ? x0 : x1) + (size_t)((m < NCTX) ? m : m - NCTX) * D_MODEL * (XB ? 2 : 4);
        const int cond = (m < NCTX) ? 0 : 1 + ((m - NCTX) >> 10);
        const float* sh = mod_l + (size_t)cond * 12288 + shift_idx * 2048; const float* scl = sh + 2048;
        f32x4 v[8]; float ss = 0.f;
        u32x2 xb[8]; f32x4 xf[8]; f32x4 gg[8], s1[8], s0[8];
#pragma unroll
        for (int j = 0; j < 8; ++j) { if (XB) xb[j] = *(const u32x2*)(xr + 8 * (64 * j + lane)); else xf[j] = *(const f32x4*)(xr + 16 * (64 * j + lane)); }
        const bool comb = XB && part != nullptr && m >= NCTX;
#pragma unroll
        for (int j = 0; j < 8; ++j) { if (XB) v[j] = (f32x4){bf_lo(xb[j].x), bf_hi(xb[j].x), bf_lo(xb[j].y), bf_hi(xb[j].y)}; else v[j] = xf[j]; }
        if (comb) {
#pragma unroll
            for (int jh = 0; jh < 2; ++jh) { u32x2 pw[4][4]; f32x4 pg[4];
#pragma unroll
                for (int j4 = 0; j4 < 4; ++j4) { const int k = 4 * (64 * (4 * jh + j4) + lane); pg[j4] = *(const f32x4*)(pgate + (size_t)cond * 12288 + k);
#pragma unroll
                    for (int q = 0; q < 4; ++q) pw[j4][q] = *(const u32x2*)(part + ((size_t)q * NLAT + (m - NCTX)) * D_MODEL + k); }
#pragma unroll
                for (int j4 = 0; j4 < 4; ++j4) { f32x4 ps = (f32x4){0.f, 0.f, 0.f, 0.f};
#pragma unroll
                    for (int q = 0; q < 4; ++q) ps += (f32x4){bf_lo(pw[j4][q].x), bf_hi(pw[j4][q].x), bf_lo(pw[j4][q].y), bf_hi(pw[j4][q].y)};
                    v[4 * jh + j4] += pg[j4] * ps; }
                __builtin_amdgcn_sched_barrier(0); }
        }
#pragma unroll
        for (int j = 0; j < 8; ++j) ss += (v[j].x * v[j].x + v[j].y * v[j].y) + (v[j].z * v[j].z + v[j].w * v[j].w);
        __builtin_amdgcn_sched_barrier(0);
#pragma unroll
        for (int j = 0; j < 8; ++j) { const int k = 4 * (64 * j + lane); gg[j] = *(const f32x4*)(g + k); s1[j] = *(const f32x4*)(scl + k); s0[j] = *(const f32x4*)(sh + k); }
        const float rstd = rsqrtf(wave_sum(ss) * (1.f / D_MODEL) + EPS);
#pragma unroll
        for (int j = 0; j < 8; ++j) { const int k = 4 * (64 * j + lane);
            if (comb) { u32x2 o; o.x = cvt_pk_bf16(v[j].x, v[j].y); o.y = cvt_pk_bf16(v[j].z, v[j].w); *(u32x2*)(xw + (size_t)m * D_MODEL + k) = o; }
            const f32x4 y = v[j] * rstd * gg[j] * (s1[j] + 1.f) + s0[j];
            u32x2 o; o.x = cvt_pk_bf16(y.x, y.y); o.y = cvt_pk_bf16(y.z, y.w);
            *(u32x2*)(h + (size_t)m * D_MODEL + k) = o; }
    }
}

__device__ __forceinline__ void conv_fixup(const float* eraw, const float* ecv, const float* cw, bf16_t* act, unsigned* cnt, int tid, int G) {
    for (int i = blockIdx.x * 512 + tid; i < 12 * D_FF; i += G * 512) {
        const int r = i / D_FF, c = i - r * D_FF, bd = r >> 1, side = r & 1;
        const int ltl = bd + bd / 3, pn = c >> 7, w = c & 127;
        const int lt_own = ltl + side, lt_nb = ltl + 1 - side;
        const size_t o_own = ((size_t)(lt_own * 2 + (1 - side)) * 44 + pn) * 256 + w, o_nb = ((size_t)(lt_nb * 2 + side) * 44 + pn) * 256 + w;
        const int tap = side ? 0 : 2;
        const float gg = ecv[o_own] + cw[(size_t)tap * D_FF2 + c] * eraw[o_nb];
        const float vv = ecv[o_own + 128] + cw[(size_t)tap * D_FF2 + D_FF + c] * eraw[o_nb + 128];
        const float o = gg * sigmoidf_(gg) * vv;
        *(unsigned short*)(act + (size_t)(NCTX + 256 * lt_own + (side ? 0 : 255)) * D_FF + c) = (unsigned short)f2bf(o);
    }
    const bool had = (int)blockIdx.x * 512 < 12 * D_FF;
    if (had) { asm volatile("s_waitcnt vmcnt(0)" ::: "memory"); __syncthreads(); }
    if (tid == 0) {
        if (had) { __builtin_amdgcn_fence(__ATOMIC_RELEASE, "agent"); asm volatile("s_waitcnt vmcnt(0)" ::: "memory"); }
        (void)__hip_atomic_fetch_add(cnt, 1u, __ATOMIC_RELAXED, __HIP_MEMORY_SCOPE_AGENT);
    }
}

__device__ __forceinline__ void combine_phase(const bf16_t* hf, const bf16_t* hb, const bf16_t* proj, const float* mlg, bf16_t* mix, int lane, int wave, int G) {
    const int gw = blockIdx.x * 8 + wave, NGW = G * 8;
    float gg[16]; load8_f32(mlg + 16 * lane, gg); load8_f32(mlg + 16 * lane + 8, gg + 8);
    u32x4 ra[2], rb[2], ro[2];
#define CMB_LOAD(mm) do { ra[0] = *(const u32x4*)(hf + (size_t)(mm) * 1024 + 16 * lane); ra[1] = *(const u32x4*)(hf + (size_t)(mm) * 1024 + 16 * lane + 8); \
        rb[0] = *(const u32x4*)(hb + (size_t)(mm) * 1024 + 16 * lane); rb[1] = *(const u32x4*)(hb + (size_t)(mm) * 1024 + 16 * lane + 8); \
        ro[0] = *(const u32x4*)(proj + (size_t)(mm) * IN_EVEN_PAD + 6144 + 16 * lane); ro[1] = *(const u32x4*)(proj + (size_t)(mm) * IN_EVEN_PAD + 6144 + 16 * lane + 8); } while (0)
    if (gw < MTOK) CMB_LOAD(gw);
    for (int m = gw; m < MTOK; m += NGW) {
        float v[16], ob[16]; float ss = 0.f;
        { float fb[16]; unpack8(ra[0], v); unpack8(ra[1], v + 8); unpack8(rb[0], fb); unpack8(rb[1], fb + 8); unpack8(ro[0], ob); unpack8(ro[1], ob + 8);
#pragma unroll
          for (int j = 0; j < 16; ++j) v[j] += fb[j]; }
        asm volatile("" ::: "memory");
        if (m + NGW < MTOK) CMB_LOAD(m + NGW);
#pragma unroll
        for (int j = 0; j < 16; ++j) ss += v[j] * v[j];
        ss += __shfl_xor(ss, 1); ss += __shfl_xor(ss, 2); ss += __shfl_xor(ss, 4);
        const float rstd = rsqrtf(ss * (1.f / 128.f) + EPS);
        float o[16];
#pragma unroll
        for (int j = 0; j < 16; ++j) o[j] = sigmoidf_(ob[j]) * (v[j] * rstd * gg[j]);
        bf16_t* op = mix + (size_t)m * D_MODEL + 1024 + 16 * lane;
        *(u32x4*)op = pack8(o); *(u32x4*)(op + 8) = pack8(o + 8);
    }
#undef CMB_LOAD
}

constexpr int AT_BUF = 71680, AT_K = 0, AT_V = 34816, AT_RPB = 143360, AT_KP = 272, AT_VP = 288;
__device__ __forceinline__ int clampi(int v, int lo, int hi) { return v < lo ? lo : (v > hi ? hi : v); }

template <int MODE>
__device__ __forceinline__ void attn_unit(const Args& a, LAS unsigned char* lds, int unit, int tid, int lane, int wave) {
    asm volatile("" : "+v"(tid), "+v"(lane)); asm volatile("" : "+s"(wave));
    constexpr bool ODD = MODE >= 2, LAT = (MODE & 1) != 0;
    constexpr int LD = ODD ? IN_ODD : IN_EVEN_PAD;
    const int fr = lane & 15, g = lane >> 4, tq = (lane >> 2) & 3, tp = lane & 3;
    const bf16_t* proj = (const bf16_t*)(a.ws + WS_PROJ);
    bf16_t* mix = (bf16_t*)(a.ws + WS_MIX);
    int b, h, u;
    if (!LAT) { b = unit >> 3; h = unit & 7; u = 0; } else { b = unit >> 6; h = (unit >> 3) & 7; u = unit & 7; }
    const int tok0 = LAT ? NCTX + b * 1024 : b * 256;
    const float* gq = a.in[ODD ? I_DGQ : I_NAGQ]; const float* gk = a.in[ODD ? I_DGK : I_NAGK];
    int n_own, n_cache, rlo = 0;
    if (!LAT) { n_own = 2; n_cache = 0; }
    else if (MODE == 1) { rlo = clampi(2 * u - 4, 0, 8); const int rhi = clampi(2 * u + 1 - 4, 0, 8) + 7; n_own = (rhi - rlo + 2) >> 1; n_cache = 4; }
    else { n_own = 8; n_cache = 4; }
    const int ntile = n_own + n_cache;
    const int r_w = 2 * u + (wave >> 2), r0w = clampi(r_w - 4, 0, 8), qc = 16 * (wave & 3) + fr;
    float lam = 0.f;
#define AT_LAM() do { if (ODD) { const float* dl = a.in[I_DLAM]; const float p01 = wave_sum(dl[lane] * dl[64 + lane]), p23 = wave_sum(dl[128 + lane] * dl[192 + lane]); lam = __expf(p01) - __expf(p23) + LAM_INIT1; } } while (0)
    if (MODE == 1) { LAS float* rp = (LAS float*)(lds + AT_RPB); for (int i = tid; i < 15 * 31; i += 512) rp[i] = a.in[I_RPB][h * 465 + i] * 1.4426950408889634f; }
    float* outk = a.out + (ODD ? O_DK : O_NAK) + (size_t)(b * 8 + h) * 256 * 128;
    float* outv = a.out + (ODD ? O_DV : O_NAV) + (size_t)(b * 8 + h) * 256 * 128;
    const float* cK = a.in[ODD ? I_CDK : I_CNAK] + (size_t)(b * 8 + h) * 512 * 128;
    const float* cV = a.in[ODD ? I_CDV : I_CNAV] + (size_t)(b * 8 + h) * 512 * 128;

    f32x4 raw_[2][4];
    float ggk_[8] = {0.f, 0.f, 0.f, 0.f, 0.f, 0.f, 0.f, 0.f};
#define AT_KBASE(tt) ((tt) < n_own ? ((MODE == 1) ? (rlo + 2 * (tt)) * 64 : 128 * (tt)) : 128 * ((tt) - n_own))
#define AT_LOAD_HALF(tt, hf) AT_LOAD_HALF_R(tt, hf, raw_)
#define AT_LOAD_HALF_R(tt, hf, RW) do { const int kb0_ = AT_KBASE(tt) + 64 * (hf); \
        if ((tt) < n_own) { _Pragma("unroll") for (int i = 0; i < 2; ++i) { const int p_ = tid + 512 * i; const bf16_t* src = proj + (size_t)(tok0 + kb0_ + (p_ >> 4)) * LD + h * 128 + 8 * (p_ & 15); \
                RW[i][0] = *(const f32x4*)(src + 1024); RW[i][1] = *(const f32x4*)(src + 2048); } } \
        else if (LAT) { _Pragma("unroll") for (int i = 0; i < 2; ++i) { const int p_ = tid + 512 * i; const size_t o_ = (size_t)(kb0_ + (p_ >> 4)) * 128 + 8 * (p_ & 15); \
                RW[i][0] = *(const f32x4*)(cK + o_); RW[i][1] = *(const f32x4*)(cK + o_ + 4); RW[i][2] = *(const f32x4*)(cV + o_); RW[i][3] = *(const f32x4*)(cV + o_ + 4); } } } while (0)
#define AT_WRITE_HALF(tt, hf) AT_WRITE_HALF_R(tt, hf, raw_, false)
#define AT_WRITE_HALF_R(tt, hf, RW, PREG) do { const bool own_ = (tt) < n_own; const int kb0_ = AT_KBASE(tt) + 64 * (hf); LAS unsigned char* bufp_ = lds + ((tt) & 1) * AT_BUF; \
        _Pragma("unroll") for (int i = 0; i < 2; ++i) { const int p_ = tid + 512 * i, row_ = p_ >> 4, c_ = p_ & 15; float kv[8]; \
            if (own_) { unpack8(__builtin_bit_cast(u32x4, RW[i][0]), kv); float ss_ = 0.f; \
                _Pragma("unroll") for (int j = 0; j < 8; ++j) ss_ += kv[j] * kv[j]; \
                ss_ += __shfl_xor(ss_, 1); ss_ += __shfl_xor(ss_, 2); ss_ += __shfl_xor(ss_, 4); float rs_; \
                if (!ODD) { ss_ += __shfl_xor(ss_, 8); rs_ = rsqrtf(ss_ * (1.f / 128.f) + EPS); } else rs_ = rsqrtf(ss_ * (1.f / 64.f) + EPS); \
                float gg_[8]; if (PREG) { _Pragma("unroll") for (int j = 0; j < 8; ++j) gg_[j] = ggk_[j]; } else load8_f32(gk + (ODD ? 8 * (c_ & 7) : 8 * c_), gg_); \
                _Pragma("unroll") for (int j = 0; j < 8; ++j) kv[j] *= rs_ * gg_[j]; \
                if (!LAT) { float vv_[8]; unpack8(__builtin_bit_cast(u32x4, RW[i][1]), vv_); store8_f32(outk + (size_t)(kb0_ + row_) * 128 + 8 * c_, kv); store8_f32(outv + (size_t)(kb0_ + row_) * 128 + 8 * c_, vv_); } \
                if (MODE == 3) { const int kpos_ = kb0_ + row_; const int pos_ = ((c_ & 7) >> 2) ? (kpos_ & 63) : (kpos_ >> 6); const float* rt_ = (const float*)(a.ws + WS_ROPE) + (pos_ * 16 + 8 * (c_ & 1)) * 2; \
                    _Pragma("unroll") for (int j2 = 0; j2 < 4; ++j2) { const f32x4 t4_ = *(const f32x4*)(rt_ + 4 * j2); \
                        _Pragma("unroll") for (int e = 0; e < 2; ++e) { const int j = 2 * j2 + e; const float cs_ = t4_[2 * e], sn_ = t4_[2 * e + 1]; const float pr_ = __shfl_xor(kv[j], 2); \
                            kv[j] = ((c_ & 3) < 2) ? kv[j] * cs_ - pr_ * sn_ : kv[j] * cs_ + pr_ * sn_; } } } \
                *(LAS u32x4*)(bufp_ + AT_V + (64 * (hf) + row_) * AT_VP + c_ * 16) = __builtin_bit_cast(u32x4, RW[i][1]); \
            } else { float vv_[8]; \
                _Pragma("unroll") for (int j = 0; j < 4; ++j) { kv[j] = RW[i][0][j]; kv[4 + j] = RW[i][1][j]; vv_[j] = RW[i][2][j]; vv_[4 + j] = RW[i][3][j]; } \
                *(LAS u32x4*)(bufp_ + AT_V + (64 * (hf) + row_) * AT_VP + c_ * 16) = pack8(vv_); } \
            *(LAS u32x4*)(bufp_ + AT_K + (64 * (hf) + row_) * AT_KP + c_ * 16) = pack8(kv); } } while (0)

#define AT_QLOAD(qi_, QR) do { const bf16_t* qp = proj + (size_t)(tok0 + (qi_)) * LD + h * 128 + 8 * g; _Pragma("unroll") for (int ks = 0; ks < 4; ++ks) QR[ks] = *(const u32x4*)(qp + 32 * ks); } while (0)
#define AT_QPREP(qi_) do { u32x4 qr1_[4]; AT_QLOAD(qi_, qr1_); AT_QPREP_R(qi_, qr1_); } while (0)
#define AT_QPREP_R(qi_, QR) do { float qv[4][8]; \
        _Pragma("unroll") for (int ks = 0; ks < 4; ++ks) unpack8(QR[ks], qv[ks]); \
        if (!ODD) { float ss = 0.f; \
            _Pragma("unroll") for (int ks = 0; ks < 4; ++ks) _Pragma("unroll") for (int j = 0; j < 8; ++j) ss += qv[ks][j] * qv[ks][j]; \
            ss += __shfl_xor(ss, 16); ss += __shfl_xor(ss, 32); const float rs = rsqrtf(ss * (1.f / 128.f) + EPS) * (0.08838834764831845f * 1.4426950408889634f);       \
            _Pragma("unroll") for (int ks = 0; ks < 4; ++ks) { float gg[8]; load8_f32(gq + 32 * ks + 8 * g, gg); _Pragma("unroll") for (int j = 0; j < 8; ++j) qv[ks][j] *= rs * gg[j]; } \
        } else { float s0_ = 0.f, s1_ = 0.f; \
            _Pragma("unroll") for (int j = 0; j < 8; ++j) { s0_ += qv[0][j] * qv[0][j] + qv[1][j] * qv[1][j]; s1_ += qv[2][j] * qv[2][j] + qv[3][j] * qv[3][j]; } \
            s0_ += __shfl_xor(s0_, 16); s0_ += __shfl_xor(s0_, 32); s1_ += __shfl_xor(s1_, 16); s1_ += __shfl_xor(s1_, 32); \
            const float r0_ = rsqrtf(s0_ * (1.f / 64.f) + EPS) * (0.125f * 1.4426950408889634f), r1_ = rsqrtf(s1_ * (1.f / 64.f) + EPS) * (0.125f * 1.4426950408889634f); \
            _Pragma("unroll") for (int ks = 0; ks < 4; ++ks) { float gg[8]; load8_f32(gq + 32 * (ks & 1) + 8 * g, gg); _Pragma("unroll") for (int j = 0; j < 8; ++j) qv[ks][j] *= (ks < 2 ? r0_ : r1_) * gg[j]; } \
            if (LAT) { _Pragma("unroll") for (int ks = 0; ks < 4; ++ks) { const int pos = (ks & 1) ? ((qi_) & 63) : ((qi_) >> 6); const float* rt = (const float*)(a.ws + WS_ROPE) + (pos * 16 + 8 * (g & 1)) * 2; \
                    _Pragma("unroll") for (int j2 = 0; j2 < 4; ++j2) { const f32x4 t4 = *(const f32x4*)(rt + 4 * j2); \
                        _Pragma("unroll") for (int e = 0; e < 2; ++e) { const int j = 2 * j2 + e; const float cs = t4[2 * e], sn = t4[2 * e + 1]; const float pr = __shfl_xor(qv[ks][j], 32); \
                            qv[ks][j] = (g < 2) ? qv[ks][j] * cs - pr * sn : qv[ks][j] * cs + pr * sn; } } } } } \
        _Pragma("unroll") for (int ks = 0; ks < 4; ++ks) Yq[ks] = as_bf16x8(pack8(qv[ks])); } while (0)

#define ATB 8
#define MLB 4
#define AT_SUBTILE(bf_, sub_, local_, kr_) do { \
        bool valid_ = true; if (MODE == 1 && (local_)) valid_ = ((kr_) >= r0w) && ((kr_) < r0w + 8); \
        if (valid_) { const LAS unsigned char* kb_p = lds + (bf_) * AT_BUF + AT_K + (64 * (sub_) + fr) * AT_KP + (8 * g) * 2; \
            const LAS unsigned char* vb_p = lds + (bf_) * AT_BUF + AT_V + (64 * (sub_) + 4 * g + tq) * AT_VP + (4 * tp) * 2; \
            f32x4 s0[4], s1[4]; \
            _Pragma("unroll") for (int kb = 0; kb < 4; ++kb) { s0[kb] = (f32x4){0.f, 0.f, 0.f, 0.f}; s1[kb] = (f32x4){0.f, 0.f, 0.f, 0.f}; } \
            if (false) { \
            _Pragma("unroll") for (int kb = 0; kb < 4; ++kb) _Pragma("unroll") for (int ks = 0; ks < 4; ++ks) { const bf16x8 kf = *(const LAS bf16x8*)(kb_p + (16 * kb) * AT_KP + 64 * ks); \
                if (!ODD || ks < 2) s0[kb] = MFMA16(kf, Yq[ks], s0[kb]); else s1[kb] = MFMA16(kf, Yq[ks], s1[kb]); } \
            } else { \
            _Pragma("unroll") for (int kp = 0; kp < 16 / ATB; ++kp) { bf16x8 kf[ATB];       \
                _Pragma("unroll") for (int e = 0; e < ATB; ++e) kf[e] = *(const LAS bf16x8*)(kb_p + (16 * ((ATB * kp + e) >> 2)) * AT_KP + 64 * (e & 3)); \
                __builtin_amdgcn_sched_barrier(0); \
                _Pragma("unroll") for (int e = 0; e < ATB; ++e) { const int kb = (ATB * kp + e) >> 2, ks = e & 3; \
                    if (!ODD || ks < 2) s0[kb] = MFMA16(kf[e], Yq[ks], s0[kb]); else s1[kb] = MFMA16(kf[e], Yq[ks], s1[kb]); } \
                __builtin_amdgcn_sched_barrier(0); } } \
            if (MODE == 1 && (local_)) { const LAS float* rp = (const LAS float*)(lds + AT_RPB) + ((kr_) - r_w + 7) * 31; const int col0 = clampi(qc - 8, 0, 48); \
                float bz_[16]; \
                _Pragma("unroll") for (int kb = 0; kb < 4; ++kb) _Pragma("unroll") for (int i = 0; i < 4; ++i) { bz_[4 * kb + i] = rp[clampi(16 * kb + 4 * g + i - qc + 15, 0, 30)]; asm volatile("" : "+v"(bz_[4 * kb + i])); }     \
                _Pragma("unroll") for (int kb = 0; kb < 4; ++kb) _Pragma("unroll") for (int i = 0; i < 4; ++i) { const int kc = 16 * kb + 4 * g + i; const bool ok = (kc >= col0) && (kc < col0 + 16); \
                    s0[kb][i] = ok ? s0[kb][i] + bz_[4 * kb + i] : -1e30f; } } \
            bf16x8 P0[2], P1[2]; \
            { float mx = -1e30f; \
              _Pragma("unroll") for (int kb = 0; kb < 4; ++kb) _Pragma("unroll") for (int i = 0; i < 4; ++i) mx = fmaxf(mx, s0[kb][i]); \
              mx = fmaxf(mx, __shfl_xor(mx, 16)); mx = fmaxf(mx, __shfl_xor(mx, 32)); \
              const float mn = fmaxf(m0, mx), al = __builtin_amdgcn_exp2f(m0 - mn); m0 = mn; float rs = 0.f; \
              _Pragma("unroll") for (int kb = 0; kb < 4; ++kb) _Pragma("unroll") for (int i = 0; i < 4; ++i) { const float p = __builtin_amdgcn_exp2f(s0[kb][i] - mn); if (ODD) rs += p; s0[kb][i] = p; } \
              if (ODD) { rs += __shfl_xor(rs, 16); rs += __shfl_xor(rs, 32); l0 = l0 * al + rs; } else lacc *= al;        \
              _Pragma("unroll") for (int d = 0; d < 8; ++d) o0[d] *= al; \
              _Pragma("unroll") for (int tt = 0; tt < 2; ++tt) { u32x4 w; w.x = cvt_pk_bf16(s0[2 * tt][0], s0[2 * tt][1]); w.y = cvt_pk_bf16(s0[2 * tt][2], s0[2 * tt][3]); w.z = cvt_pk_bf16(s0[2 * tt + 1][0], s0[2 * tt + 1][1]); w.w = cvt_pk_bf16(s0[2 * tt + 1][2], s0[2 * tt + 1][3]); P0[tt] = as_bf16x8(w); } } \
            if (ODD) { float mx = -1e30f; \
              _Pragma("unroll") for (int kb = 0; kb < 4; ++kb) _Pragma("unroll") for (int i = 0; i < 4; ++i) mx = fmaxf(mx, s1[kb][i]); \
              mx = fmaxf(mx, __shfl_xor(mx, 16)); mx = fmaxf(mx, __shfl_xor(mx, 32)); \
              const float mn = fmaxf(m1, mx), al = __builtin_amdgcn_exp2f(m1 - mn); m1 = mn; float rs = 0.f; \
              _Pragma("unroll") for (int kb = 0; kb < 4; ++kb) _Pragma("unroll") for (int i = 0; i < 4; ++i) { const float p = __builtin_amdgcn_exp2f(s1[kb][i] - mn); rs += p; s1[kb][i] = p; } \
              rs += __shfl_xor(rs, 16); rs += __shfl_xor(rs, 32); l1 = l1 * al + rs; \
              _Pragma("unroll") for (int d = 0; d < 8; ++d) o1[d] *= al; \
              _Pragma("unroll") for (int tt = 0; tt < 2; ++tt) { u32x4 w; w.x = cvt_pk_bf16(s1[2 * tt][0], s1[2 * tt][1]); w.y = cvt_pk_bf16(s1[2 * tt][2], s1[2 * tt][3]); w.z = cvt_pk_bf16(s1[2 * tt + 1][0], s1[2 * tt + 1][1]); w.w = cvt_pk_bf16(s1[2 * tt + 1][2], s1[2 * tt + 1][3]); P1[tt] = as_bf16x8(w); } } \
            if (false) { \
            _Pragma("unroll") for (int d = 0; d < 8; ++d) _Pragma("unroll") for (int tt = 0; tt < 2; ++tt) { const LAS unsigned char* vp = vb_p + (32 * tt) * AT_VP + 32 * d; \
                const u32x2 lo = lds_tr(vp), hi = lds_tr(vp + 16 * AT_VP); const bf16x8 vf = as_bf16x8((u32x4){lo.x, lo.y, hi.x, hi.y}); \
                o0[d] = MFMA16(vf, P0[tt], o0[d]); if (ODD) o1[d] = MFMA16(vf, P1[tt], o1[d]); } \
            } else { \
            _Pragma("unroll") for (int tb = 0; tb < 16 / ATB; ++tb) { bf16x8 vf[ATB]; \
                _Pragma("unroll") for (int e = 0; e < ATB; ++e) { const int tt = (ATB * tb + e) >> 3, d = (ATB * tb + e) & 7; const LAS unsigned char* vp = vb_p + (32 * tt) * AT_VP + 32 * d; \
                    const u32x2 lo = lds_tr(vp), hi = lds_tr(vp + 16 * AT_VP); vf[e] = as_bf16x8((u32x4){lo.x, lo.y, hi.x, hi.y}); } \
                __builtin_amdgcn_sched_barrier(0); \
                if (!ODD && ((ATB * tb) & 7) == 0) lacc = MFMA16(as_bf16x8((u32x4){0x3f803f80u, 0x3f803f80u, 0x3f803f80u, 0x3f803f80u}), P0[(ATB * tb) >> 3], lacc);        \
                _Pragma("unroll") for (int e = 0; e < ATB; ++e) { const int tt = (ATB * tb + e) >> 3, d = (ATB * tb + e) & 7; o0[d] = MFMA16(vf[e], P0[tt], o0[d]); if (ODD) o1[d] = MFMA16(vf[e], P1[tt], o1[d]); } \
                __builtin_amdgcn_sched_barrier(0); } } } } while (0)

#define AT_FINAL(qi_) do { bf16_t* op = mix + (size_t)(tok0 + (qi_)) * D_MODEL + h * 128 + 4 * g; \
        if (!ODD) { const float inv = 1.f / lacc[0]; \
            _Pragma("unroll") for (int d = 0; d < 8; ++d) { u32x2 w; w.x = cvt_pk_bf16(o0[d][0] * inv, o0[d][1] * inv); w.y = cvt_pk_bf16(o0[d][2] * inv, o0[d][3] * inv); *(u32x2*)(op + 16 * d) = w; } \
        } else { const float i0 = 1.f / l0, i1 = lam / l1; float ss = 0.f; \
            _Pragma("unroll") for (int d = 0; d < 8; ++d) _Pragma("unroll") for (int i = 0; i < 4; ++i) { const float v = o0[d][i] * i0 - o1[d][i] * i1; o0[d][i] = v; ss += v * v; } \
            ss += __shfl_xor(ss, 16); ss += __shfl_xor(ss, 32); const float rs = rsqrtf(ss * (1.f / 128.f) + EPS) * (1.f - LAM_INIT1); const float* go = a.in[I_DGOUT] + h * 128 + 4 * g; f32x4 ggo_[8]; \
            _Pragma("unroll") for (int d = 0; d < 8; ++d) ggo_[d] = *(const f32x4*)(go + 16 * d);       \
            _Pragma("unroll") for (int d = 0; d < 8; ++d) { const f32x4 gg = ggo_[d]; u32x2 w; w.x = cvt_pk_bf16(o0[d][0] * rs * gg.x, o0[d][1] * rs * gg.y); w.y = cvt_pk_bf16(o0[d][2] * rs * gg.z, o0[d][3] * rs * gg.w); *(u32x2*)(op + 16 * d) = w; } } } while (0)
#define AT_INIT() do { _Pragma("unroll") for (int d = 0; d < 8; ++d) { o0[d] = (f32x4){0.f, 0.f, 0.f, 0.f}; o1[d] = (f32x4){0.f, 0.f, 0.f, 0.f}; } m0 = -1e30f; m1 = -1e30f; l0 = 0.f; l1 = 0.f; lacc = (f32x4){0.f, 0.f, 0.f, 0.f}; } while (0)

    bf16x8 Yq[4];
    f32x4 o0[8], o1[8];
    float m0, m1, l0, l1; f32x4 lacc;
    __syncthreads();
    if (!LAT) {
        f32x4 rawc[4][2][4]; u32x4 qr_[4];
#pragma unroll
        for (int t2 = 0; t2 < 2; ++t2)
#pragma unroll
            for (int hf = 0; hf < 2; ++hf) AT_LOAD_HALF_R(t2, hf, rawc[2 * t2 + hf]);
        load8_f32(gk + (ODD ? 8 * (lane & 7) : 8 * (lane & 15)), ggk_);
        AT_QLOAD(16 * wave + fr, qr_);
        AT_LAM();
#pragma unroll
        for (int t2 = 0; t2 < 2; ++t2)
#pragma unroll
            for (int hf = 0; hf < 2; ++hf) AT_WRITE_HALF_R(t2, hf, rawc[2 * t2 + hf], true);
        __syncthreads();
        for (int qb = 0; qb < 2; ++qb) {
            const int qi = 128 * qb + 16 * wave + fr;
            AT_QPREP_R(qi, qr_); AT_INIT();
if (ODD) {
#pragma unroll 1
                for (int st = 0; st < 4; ++st) AT_SUBTILE(st >> 1, st & 1, false, 0);
            } else {
#pragma unroll
                for (int st = 0; st < 4; ++st) AT_SUBTILE(st >> 1, st & 1, false, 0);
            }
            if (qb == 0) AT_QLOAD(128 + 16 * wave + fr, qr_);
            AT_FINAL(qi);
        }
    } else {
        const int qi = 128 * u + 16 * wave + fr;
        AT_LOAD_HALF(0, 0); AT_LAM(); AT_WRITE_HALF(0, 0); AT_LOAD_HALF(0, 1); AT_WRITE_HALF(0, 1);
        AT_QPREP(qi); AT_INIT();
        __syncthreads();
        for (int t = 0; t < ntile; ++t) {
            const bool more = t + 1 < ntile, local = (MODE == 1) && (t < n_own);
            const int kr0 = rlo + 2 * t;
            if (more) AT_LOAD_HALF(t + 1, 0);
            AT_SUBTILE(t & 1, 0, local, kr0);
            if (more) { AT_WRITE_HALF(t + 1, 0); AT_LOAD_HALF(t + 1, 1); }
            AT_SUBTILE(t & 1, 1, local, kr0 + 1);
            if (more) AT_WRITE_HALF(t + 1, 1);
            __syncthreads();
        }
        AT_FINAL(qi);
    }
#undef AT_KBASE
#undef AT_LOAD_HALF
#undef AT_WRITE_HALF
#undef AT_QPREP
#undef AT_QPREP_R
#undef AT_QLOAD
#undef AT_LAM
#undef AT_LOAD_HALF_R
#undef AT_WRITE_HALF_R
#undef AT_SUBTILE
#undef AT_FINAL
#undef AT_INIT
}

constexpr int ML_KT = 0, ML_KW = 34816, ML_VT = 71680, ML_CT = 108544, ML_ARR = 143360, ML_P = 272, ML_Q = 288;
__device__ __forceinline__ void mlstm_unit(const Args& a, LAS unsigned char* lds, bool lat, int idx, int tid, int lane, int wave) {
    asm volatile("" : "+v"(tid), "+v"(lane)); asm volatile("" : "+s"(wave));
    const int fr = lane & 15, g = lane >> 4;
    const bf16_t* proj = (const bf16_t*)(a.ws + WS_PROJ);
    const float* gates = (const float*)(a.ws + WS_GATES);
    const int b = idx >> 4, h = (idx >> 1) & 7, dir = idx & 1;
    const int S = lat ? 1024 : 256, nc = S / 128, tok0 = lat ? NCTX + b * 1024 : b * 256;
    bf16_t* hbuf = (bf16_t*)(a.ws + (dir ? WS_HB : WS_HF));
    LAS float* BB = (LAS float*)(lds + ML_ARR); LAS float* AA = BB + 128; LAS float* PM = BB + 256; LAS float* WS_ = BB + 384; LAS float* NN = BB + 512; LAS float* SCAL = BB + 640;
    const size_t sidx = (size_t)((b * 2 + dir) * 8 + h);
    const int jrow = 16 * wave + fr;
#define ML_TOK(c, p) (tok0 + (dir ? (S - 1 - (128 * (c) + (p))) : (128 * (c) + (p))))
#define ML_GATE_LOAD(cc) do { \
        const float* g0 = gates + (size_t)ML_TOK(cc, 2 * lane) * 32 + (2 * dir) * 8 + h; const float* g1 = gates + (size_t)ML_TOK(cc, 2 * lane + 1) * 32 + (2 * dir) * 8 + h; \
        gpre[0] = g0[0]; gpre[1] = g0[8]; gpre[2] = g1[0]; gpre[3] = g1[8]; } while (0)
#define ML_GATE_SCAN(cc, m_in) do { \
        const float i0 = gpre[0], f0 = logsigmoid_(gpre[1]), i1 = gpre[2], f1 = logsigmoid_(gpre[3]); \
        const float pair = f0 + f1; float inc = pair; \
        _Pragma("unroll") for (int o = 1; o < 64; o <<= 1) { const float t_ = __shfl_up(inc, o); if (lane >= o) inc += t_; } \
        const float b0 = (inc - pair) + f0, b1 = inc, a0 = i0 - b0, a1 = i1 - b1; \
        float incm = fmaxf(a0, a1); \
        _Pragma("unroll") for (int o = 1; o < 64; o <<= 1) { const float t_ = __shfl_up(incm, o); if (lane >= o) incm = fmaxf(incm, t_); } \
        float excm = __shfl_up(incm, 1); if (lane == 0) excm = -3.0e38f; \
        const float bl_ = __shfl(inc, 63), pmf_ = __shfl(incm, 63), mn_ = bl_ + fmaxf((m_in), pmf_); \
        BB[2 * lane] = b0; BB[2 * lane + 1] = b1; AA[2 * lane] = a0; AA[2 * lane + 1] = a1; PM[2 * lane] = fmaxf(excm, a0); PM[2 * lane + 1] = incm; \
        WS_[2 * lane] = __expf(bl_ + a0 - mn_); WS_[2 * lane + 1] = __expf(bl_ + a1 - mn_); \
        if (lane == 0) { SCAL[0] = bl_; SCAL[1] = pmf_; } } while (0)
#define ML_PREFETCH(cc) do { \
        _Pragma("unroll") for (int i = 0; i < 4; ++i) { const int p_ = tid + 512 * i; const bf16_t* src = proj + (size_t)ML_TOK(cc, p_ >> 4) * IN_EVEN_PAD + h * 128 + 8 * (p_ & 15); \
            kreg[i] = *(const u32x4*)(src + 4096); } \
        } while (0)
    f32x4 cacc[8];
    float mst, nst;
    float gpre[4] = {0.f, 0.f, 0.f, 0.f};
    u32x4 kreg[4], vreg[4], qraw[4];
    __syncthreads();
    ML_PREFETCH(0);
    if (lat) {
        const float* c0 = a.in[I_SMC] + sidx * 16384 + (size_t)(16 * wave + 4 * g) * 128 + fr;
#pragma unroll
        for (int eb = 0; eb < 8; ++eb)
#pragma unroll
            for (int i = 0; i < 4; ++i) cacc[eb][i] = c0[i * 128 + 16 * eb];
        nst = a.in[I_SMN][sidx * 128 + 16 * wave + fr];
        mst = a.in[I_SMM][sidx];
    } else {
#pragma unroll
        for (int eb = 0; eb < 8; ++eb) cacc[eb] = (f32x4){0.f, 0.f, 0.f, 0.f};
        nst = 0.f;
        mst = 0.f;
    }
#pragma unroll
    for (int eb = 0; eb < 8; ++eb)
        { u32x2 w; w.x = cvt_pk_bf16(cacc[eb][0], cacc[eb][1]); w.y = cvt_pk_bf16(cacc[eb][2], cacc[eb][3]); *(LAS u32x2*)(lds + ML_CT + (16 * eb + fr) * ML_P + (16 * wave + 4 * g) * 2) = w; }
    if (g == 0) NN[16 * wave + fr] = nst;
    if (wave == 2) { ML_GATE_LOAD(0); ML_GATE_SCAN(0, mst); }
    __syncthreads();
    for (int c = 0; c < nc; ++c) {
        if (wave == 2 && c + 1 < nc) ML_GATE_LOAD(c + 1);
        const float bl = SCAL[0], mnew = bl + fmaxf(mst, SCAL[1]), aprev = __expf(bl + mst - mnew);
        const int tokj = ML_TOK(c, jrow);
#pragma unroll
        for (int i = 0; i < 4; ++i) { const int p_ = tid + 512 * i; vreg[i] = *(const u32x4*)(proj + (size_t)ML_TOK(c, p_ >> 4) * IN_EVEN_PAD + 5120 + h * 128 + 8 * (p_ & 15)); }
        { const bf16_t* qp = proj + (size_t)tokj * IN_EVEN_PAD + 3072 + h * 128 + 8 * g;
#pragma unroll
          for (int ks = 0; ks < 4; ++ks) qraw[ks] = *(const u32x4*)(qp + 32 * ks); }
#pragma unroll
        for (int i = 0; i < 4; ++i) {
            const int p = tid + 512 * i, s = p >> 4, c8 = p & 15;
            float kv[8]; unpack8(kreg[i], kv);
            const float w = WS_[s];
#pragma unroll
            for (int j = 0; j < 8; ++j) kv[j] *= 0.08838834764831845f;
            *(LAS u32x4*)(lds + ML_KT + s * ML_P + c8 * 16) = pack8(kv);
#pragma unroll
            for (int j = 0; j < 8; ++j) kv[j] *= w;
            *(LAS u32x4*)(lds + ML_KW + s * ML_Q + c8 * 16) = pack8(kv);
        }
        if (c + 1 < nc) ML_PREFETCH(c + 1);
#pragma unroll
        for (int i = 0; i < 4; ++i) {
            const int p = tid + 512 * i, s = p >> 4, c8 = p & 15;
            *(LAS u32x4*)(lds + ML_VT + s * ML_Q + c8 * 16) = vreg[i];
        }
        __syncthreads();
        const float bj = BB[jrow], mj = bj + fmaxf(mst, PM[jrow]), win = __expf(bj + mst - mj);
        f32x4 acc[8];
#pragma unroll
        for (int eb = 0; eb < 8; ++eb) acc[eb] = (f32x4){0.f, 0.f, 0.f, 0.f};
#pragma unroll
        for (int ks = 0; ks < 4; ++ks) { bf16x8 cf[8];
#pragma unroll
            for (int eb = 0; eb < 8; ++eb) cf[eb] = *(const LAS bf16x8*)(lds + ML_CT + (16 * eb + fr) * ML_P + (32 * ks + 8 * g) * 2);
            __builtin_amdgcn_sched_barrier(0);
#pragma unroll
            for (int eb = 0; eb < 8; ++eb) acc[eb] = MFMA16(cf[eb], as_bf16x8(qraw[ks]), acc[eb]);
            __builtin_amdgcn_sched_barrier(0); }
#pragma unroll
        for (int eb = 0; eb < 8; ++eb) acc[eb] *= win;
        __builtin_amdgcn_sched_barrier(0);
        float qn = 0.f;
#pragma unroll
        for (int ks = 0; ks < 4; ++ks) { float qf[8]; unpack8(qraw[ks], qf); const f32x4 n0 = *(const LAS f32x4*)(NN + 8 * g + 32 * ks), n1 = *(const LAS f32x4*)(NN + 8 * g + 32 * ks + 4);
            qn += (qf[0] * n0[0] + qf[1] * n0[1]) + (qf[2] * n0[2] + qf[3] * n0[3]) + (qf[4] * n1[0] + qf[5] * n1[1]) + (qf[6] * n1[2] + qf[7] * n1[3]); }
        qn += __shfl_xor(qn, 16); qn += __shfl_xor(qn, 32);
        float den = win * qn;
        f32x4 sc[8];
#pragma unroll
        for (int sb = 0; sb < 8; ++sb) sc[sb] = (f32x4){0.f, 0.f, 0.f, 0.f};
#pragma unroll
        for (int kq = 0; kq < 32 / MLB; ++kq) { bf16x8 kf[MLB];
#pragma unroll
            for (int e = 0; e < MLB; ++e) { const int ks = (MLB * kq + e) >> 3, sb = (MLB * kq + e) & 7; kf[e] = *(const LAS bf16x8*)(lds + ML_KT + (16 * sb + fr) * ML_P + (32 * ks + 8 * g) * 2); }
            __builtin_amdgcn_sched_barrier(0);
#pragma unroll
            for (int e = 0; e < MLB; ++e) { const int ks = (MLB * kq + e) >> 3, sb = (MLB * kq + e) & 7; sc[sb] = MFMA16(kf[e], as_bf16x8(qraw[ks]), sc[sb]); }
            __builtin_amdgcn_sched_barrier(0); }
        __builtin_amdgcn_sched_barrier(0);
        float dsum = 0.f;
#pragma unroll
        for (int sb = 0; sb < 8; ++sb)
            { const f32x4 a4 = *(const LAS f32x4*)(AA + 4 * g + 16 * sb);
#pragma unroll
              for (int i = 0; i < 4; ++i) { const int s = 16 * sb + 4 * g + i; const float w = (s <= jrow) ? __expf(bj + a4[i] - mj) * sc[sb][i] : 0.f; sc[sb][i] = w; dsum += w; } }
        dsum += __shfl_xor(dsum, 16); dsum += __shfl_xor(dsum, 32);
        den += dsum;
#pragma unroll
        for (int tt = 0; tt < 4; ++tt) { u32x4 w; w.x = cvt_pk_bf16(sc[2 * tt][0], sc[2 * tt][1]); w.y = cvt_pk_bf16(sc[2 * tt][2], sc[2 * tt][3]); w.z = cvt_pk_bf16(sc[2 * tt + 1][0], sc[2 * tt + 1][1]); w.w = cvt_pk_bf16(sc[2 * tt + 1][2], sc[2 * tt + 1][3]);
            const bf16x8 pf = as_bf16x8(w); bf16x8 vf[8];
#pragma unroll
            for (int eb = 0; eb < 8; ++eb) { const LAS unsigned char* vp = lds + ML_VT + (32 * tt + 4 * g + ((lane >> 2) & 3)) * ML_Q + (16 * eb + 4 * (lane & 3)) * 2;
                const u32x2 lo = lds_tr(vp), hi = lds_tr(vp + 16 * ML_Q); vf[eb] = as_bf16x8((u32x4){lo.x, lo.y, hi.x, hi.y}); }
            __builtin_amdgcn_sched_barrier(0);
#pragma unroll
            for (int eb = 0; eb < 8; ++eb) acc[eb] = MFMA16(vf[eb], pf, acc[eb]);
            __builtin_amdgcn_sched_barrier(0); }
        { const float dn = 1.f / fmaxf(fabsf(den), __expf(-mj)); bf16_t* hp = hbuf + (size_t)tokj * 1024 + h * 128 + 4 * g;
#pragma unroll
          for (int eb = 0; eb < 8; ++eb) { const f32x4 hv = acc[eb] * dn; u32x2 w; w.x = cvt_pk_bf16(hv[0], hv[1]); w.y = cvt_pk_bf16(hv[2], hv[3]); *(u32x2*)(hp + 16 * eb) = w; } }
        __builtin_amdgcn_sched_barrier(0);
        f32x4 nacc = (f32x4){0.f, 0.f, 0.f, 0.f};
#pragma unroll
        for (int eb = 0; eb < 8; ++eb) cacc[eb] *= aprev;
#pragma unroll
        for (int tt = 0; tt < 4; ++tt) { const LAS unsigned char* kp = lds + ML_KW + (32 * tt + 8 * g + ((lane >> 2) & 3)) * ML_Q + (16 * wave + 4 * (lane & 3)) * 2;
            const u32x2 klo = lds_tr(kp), khi = lds_tr(kp + 4 * ML_Q); const bf16x8 kf = as_bf16x8((u32x4){klo.x, klo.y, khi.x, khi.y}); bf16x8 vf[8];
#pragma unroll
            for (int eb = 0; eb < 8; ++eb) { const LAS unsigned char* vp = lds + ML_VT + (32 * tt + 8 * g + ((lane >> 2) & 3)) * ML_Q + (16 * eb + 4 * (lane & 3)) * 2;
                const u32x2 lo = lds_tr(vp), hi = lds_tr(vp + 4 * ML_Q); vf[eb] = as_bf16x8((u32x4){lo.x, lo.y, hi.x, hi.y}); }
            __builtin_amdgcn_sched_barrier(0);
            nacc = MFMA16(as_bf16x8((u32x4){0x3f803f80u, 0x3f803f80u, 0x3f803f80u, 0x3f803f80u}), kf, nacc);
#pragma unroll
            for (int eb = 0; eb < 8; ++eb) cacc[eb] = MFMA16(kf, vf[eb], cacc[eb]);
            __builtin_amdgcn_sched_barrier(0); }
        nst = aprev * nst + nacc[0];
        __syncthreads();
        if (g == 0) NN[16 * wave + fr] = nst;
#pragma unroll
        for (int eb = 0; eb < 8; ++eb) { u32x2 w; w.x = cvt_pk_bf16(cacc[eb][0], cacc[eb][1]); w.y = cvt_pk_bf16(cacc[eb][2], cacc[eb][3]); *(LAS u32x2*)(lds + ML_CT + (16 * eb + fr) * ML_P + (16 * wave + 4 * g) * 2) = w; }
        mst = mnew;
        if (wave == 2 && c + 1 < nc) ML_GATE_SCAN(c + 1, mst);
        __syncthreads();
    }
#undef ML_TOK
#undef ML_GATE_SCAN
#undef ML_GATE_LOAD
#undef ML_PREFETCH
    if (!lat) {
        float* co = a.out + O_MC + sidx * 16384 + (size_t)(16 * wave + 4 * g) * 128 + fr;
#pragma unroll
        for (int eb = 0; eb < 8; ++eb)
#pragma unroll
            for (int i = 0; i < 4; ++i) co[i * 128 + 16 * eb] = cacc[eb][i];
        if (g == 0) a.out[O_MN + sidx * 128 + 16 * wave + fr] = nst;
        if (tid == 0) a.out[O_MM + sidx] = mst;
    }
}

constexpr int SG_X = 0, SG_Y = 36864, SG_R = 71680, SG_P = 272, SG_Q = 288;
__device__ __forceinline__ void sgu_unit(const Args& a, LAS unsigned char* lds, int unit, int tid, int lane, int wave) {
    asm volatile("" : "+v"(tid), "+v"(lane)); asm volatile("" : "+s"(wave));
    const int fr = lane & 15, g = lane >> 4;
    const int ch = unit >> 3, grp = unit & 7, T0 = 128 * ch;
    const bf16_t* proj = (const bf16_t*)(a.ws + WS_PROJ);
    bf16_t* mix = (bf16_t*)(a.ws + WS_MIX);
    LAS float* RS = (LAS float*)(lds + SG_R);
    const int prow = 16 * wave + fr;
    float rss = 0.f; if (tid < 128) rss = ((const float*)(a.ws + WS_ROWSS))[T0 + tid];
    u32x4 xr[4]; f32x4 wr_[4][2];
#pragma unroll
    for (int i = 0; i < 4; ++i) { const int p = tid + 512 * i, row = p >> 4, c8 = p & 15;
        xr[i] = *(const u32x4*)(proj + (size_t)(T0 + row) * IN_ODD + 4096 + grp * 128 + 8 * c8);
        const float* wp = a.in[I_SGW] + (size_t)(grp * 128 + row) * 128 + 8 * c8; wr_[i][0] = *(const f32x4*)wp; wr_[i][1] = *(const f32x4*)(wp + 4); }
    const bf16_t* up = proj + (size_t)(T0 + prow) * IN_ODD + 3072 + grp * 128 + 4 * g;
    const float* sgg = a.in[I_SGG] + grp * 128 + 4 * g;
    u32x2 uw_[8]; f32x4 gg_[8];
#pragma unroll
    for (int cb = 0; cb < 8; ++cb) { uw_[cb] = *(const u32x2*)(up + 16 * cb); gg_[cb] = *(const f32x4*)(sgg + 16 * cb); }
    const float sb = a.in[I_SGB][grp * 128 + prow];
    __syncthreads();
    if (tid < 128) RS[tid] = rsqrtf(rss * (1.f / 1024.f) + EPS);
    __syncthreads();
#pragma unroll
    for (int i = 0; i < 4; ++i) {
        const int p = tid + 512 * i, row = p >> 4, c8 = p & 15;
        *(LAS u32x4*)(lds + SG_X + row * SG_Q + c8 * 16) = xr[i];
        float w[8];
#pragma unroll
        for (int j = 0; j < 4; ++j) { w[j] = wr_[i][0][j] * RS[8 * c8 + j]; w[4 + j] = wr_[i][1][j] * RS[8 * c8 + 4 + j]; }
        *(LAS u32x4*)(lds + SG_Y + row * SG_P + c8 * 16) = pack8(w);
    }
    __syncthreads();
    f32x4 acc[8];
    bf16x8 yf[4];
#pragma unroll
    for (int ks = 0; ks < 4; ++ks) yf[ks] = *(const LAS bf16x8*)(lds + SG_Y + (16 * wave + fr) * SG_P + (32 * ks + 8 * g) * 2);
#pragma unroll
    for (int cb = 0; cb < 8; ++cb) acc[cb] = (f32x4){0.f, 0.f, 0.f, 0.f};
#pragma unroll
    for (int ks = 0; ks < 4; ++ks) { bf16x8 xf[8];
#pragma unroll
        for (int cb = 0; cb < 8; ++cb) { const LAS unsigned char* xp = lds + SG_X + (32 * ks + 8 * g + ((lane >> 2) & 3)) * SG_Q + (16 * cb + 4 * (lane & 3)) * 2;
            const u32x2 lo = lds_tr(xp), hi = lds_tr(xp + 4 * SG_Q); xf[cb] = as_bf16x8((u32x4){lo.x, lo.y, hi.x, hi.y}); }
        __builtin_amdgcn_sched_barrier(0);
#pragma unroll
        for (int cb = 0; cb < 8; ++cb) acc[cb] = MFMA16(xf[cb], yf[ks], acc[cb]);
        __builtin_amdgcn_sched_barrier(0); }
    bf16_t* op = mix + (size_t)(T0 + prow) * D_MODEL + 1024 + grp * 128 + 4 * g;
#pragma unroll
    for (int cb = 0; cb < 8; ++cb) { const u32x2 uw = uw_[cb]; const f32x4 gg = gg_[cb];
        const float u0 = bf_lo(uw.x), u1 = bf_hi(uw.x), u2 = bf_lo(uw.y), u3 = bf_hi(uw.y);
        u32x2 w; w.x = cvt_pk_bf16(u0 * (acc[cb][0] * gg.x + sb), u1 * (acc[cb][1] * gg.y + sb)); w.y = cvt_pk_bf16(u2 * (acc[cb][2] * gg.z + sb), u3 * (acc[cb][3] * gg.w + sb));
        *(u32x2*)(op + 16 * cb) = w; }
}

#ifndef XTRA_E
#define XTRA_E 0
#endif
#ifndef XTRA_O
#define XTRA_O 0
#endif
#ifndef MIXE_REP
#define MIXE_REP 1
#endif
#ifndef MIXO_REP
#define MIXO_REP 1
#endif
#ifndef GEMM_REP
#define GEMM_REP 1
#endif
#ifndef ELT_REP
#define ELT_REP 1
#endif
#ifndef P0_REP
#define P0_REP 1
#endif
__global__ void __launch_bounds__(512, 2) trunk_fwd(Args args) {
    extern __shared__ __attribute__((aligned(16))) unsigned char lds_raw[];
    LAS unsigned char* lds = (LAS unsigned char*)lds_raw;
    volatile LAS unsigned* MISC = (volatile LAS unsigned*)(lds + LDS_MISC);
    const int G = gridDim.x;
    const int wave_s = __builtin_amdgcn_readfirstlane((int)(threadIdx.x >> 6));
#define lane ((int)__builtin_amdgcn_mbcnt_hi(~0u, __builtin_amdgcn_mbcnt_lo(~0u, 0u)))
#define wave (wave_s)
#define tid ((wave_s << 6) | lane)
    unsigned* ctl = (unsigned*)(args.ws + WS_CTL);
    for (int u = tid; u < (LDS_BYTES - LDS_MISC) / 4; u += 512) ((LAS unsigned*)(lds + LDS_MISC))[u] = 0u;
    __syncthreads();
    XcdBarrier bar = xcd_barrier_post(ctl + CW_BAR, MISC + 8);
    const int lo = args.ph_lo, hi = args.ph_hi;
    int ph = 0;
#define PHASE_BEGIN if (ph >= lo && ph < hi) {
#define PHASE_END   if (ph + 1 < hi) xcd_barrier(bar); } ++ph;


    PHASE_BEGIN for (int rep = 0; rep < P0_REP; ++rep) { if (rep > 0) xcd_barrier(bar); p0_prologue(args, lds, tid, lane, wave, G); } PHASE_END
#define IDLE_WORK(nunits, body) do { if (DEFER_PROLOGUE) { const int rem_ = (nunits) % G; if (rem_ != 0 && (int)blockIdx.x >= rem_) { const int widx = (int)blockIdx.x - rem_, nwork = G - rem_; body; } } } while (0)
#define LAYER_BODY(L) { \
        const float* mod_l = (const float*)(args.ws + WS_MOD) + (size_t)(L) * 3 * 12288; \
        const void* xin0 = ((L) == 0) ? (const void*)args.in[I_XP] : (const void*)(args.ws + WS_XRES); const void* xin1 = ((L) == 0) ? (const void*)args.in[I_XS] : (const void*)((const bf16_t*)(args.ws + WS_XRES) + (size_t)NCTX * D_MODEL); \
        PHASE_BEGIN for (int rep = 0; rep < ELT_REP; ++rep) norm_phase<(L) != 0>(xin0, xin1, args.in[I_GMIX] + (L) * 2048, mod_l, 0, (bf16_t*)(args.ws + WS_H), lane, wave, G, \
                (L) != 0 ? (const bf16_t*)(args.ws + WS_PART) : nullptr, (const float*)(args.ws + WS_MOD) + 5 * 2048, (bf16_t*)(args.ws + WS_XRES)); PHASE_END \
        PHASE_BEGIN { \
            pg8::Gemm gm{(const bf16_t*)(args.ws + WS_H), (const bf16_t*)(args.ws + ((L) == 0 ? WS_WINE : WS_WINO)), MTOK, (L) == 0 ? IN_EVEN_PAD : IN_ODD, 2048}; \
            pg8::StaticOrder S; S.init(gm.M, gm.N, G, (int)blockIdx.x); \
            pg8::EpiStore E{(bf16_t*)(args.ws + WS_PROJ), gm.N, (L) == 0 ? (float*)(args.ws + WS_GATES) : nullptr, args.in[I_MLB], 28, (L) == 0 ? 1000 : 12, 16, (float*)(args.ws + WS_ROWSS)}; \
            _Pragma("unroll") for (int rep = 0; rep < GEMM_REP; ++rep) pg8::gemm_phase<pg8::EpiStore, pg8::StaticOrder, true, true>(lds, gm, S, E); \
            if ((L) == 0) IDLE_WORK(S.nwg, { gemv_items(args, lds, 32, 96, widx, nwork, tid); convert_items(args, lds, CV_O, CV_W0, widx, nwork, lane, wave); }); \
            if ((L) == 1) IDLE_WORK(S.nwg, { gemv_items(args, lds, 128, 192, widx, nwork, tid); convert_items(args, lds, CV_W1, CV_U0, widx, nwork, lane, wave); }); \
        } PHASE_END \
        PHASE_BEGIN for (int rep = 0; rep < ((L) == 0 ? MIXE_REP : MIXO_REP); ++rep) { \
            if (rep > 0) xcd_barrier(bar); \
            unsigned* qh = ctl + ((L) == 0 ? CW_Q0 : CW_Q1) + 256 * rep; \
            const int total = ((L) == 0) ? (32 + 128 + 512 + 256 + XTRA_E) : (128 + 256 + 640 + XTRA_O); \
            for (;;) { \
                __syncthreads(); \
                if (tid == 0) MISC[0] = __hip_atomic_fetch_add(qh, 1u, __ATOMIC_RELAXED, __HIP_MEMORY_SCOPE_AGENT); \
                __syncthreads(); \
                const int u = (int)MISC[0]; \
                if (u >= total) break; \
                if ((L) == 0) { \
                    if (u < 32 || u >= 416) mlstm_unit(args, lds, u < 32, u < 32 ? u : u - 416, tid, lane, wave); \
                    else if (u < 160) attn_unit<1>(args, lds, u - 32, tid, lane, wave); \
                    else attn_unit<0>(args, lds, u - 160, tid, lane, wave); \
                } else { \
                    if (u < 128) attn_unit<3>(args, lds, u, tid, lane, wave); \
                    else if (u < 384) attn_unit<2>(args, lds, u - 128, tid, lane, wave); \
                    else sgu_unit(args, lds, (u - 384) % 640, tid, lane, wave); \
                } \
            } \
        } PHASE_END \
        if ((L) == 0) { \
            PHASE_BEGIN for (int rep = 0; rep < ELT_REP; ++rep) combine_phase((const bf16_t*)(args.ws + WS_HF), (const bf16_t*)(args.ws + WS_HB), (const bf16_t*)(args.ws + WS_PROJ), args.in[I_MLG], (bf16_t*)(args.ws + WS_MIX), lane, wave, G); PHASE_END \
        } \
        PHASE_BEGIN { \
            pg8::Gemm gm{(const bf16_t*)(args.ws + WS_MIX), (const bf16_t*)(args.ws + WS_WOUT) + (size_t)(L) * 2048 * 2048, MTOK, 2048, 2048}; \
            pg8::StaticOrder S; S.init(gm.M, gm.N, G, (int)blockIdx.x); \
            pg8::EpiRes<(L) != 0, true> E{xin0, xin1, (void*)(args.ws + WS_XRES), mod_l + 2 * 2048, nullptr, (bf16_t*)(args.ws + WS_H), args.in[I_GFFN] + (L) * 2048, mod_l + 4 * 2048, (float*)(args.ws + WS_RSF) + (L) * MTOK}; \
            _Pragma("unroll") for (int rep = 0; rep < ((L) == 0 ? GEMM_REP : 1); ++rep) pg8::gemm_phase<pg8::EpiRes<(L) != 0, true>, pg8::StaticOrder, true, true>(lds, gm, S, E); \
            if ((L) == 0) IDLE_WORK(S.nwg, { convert_items(args, lds, CV_U0, CV_U1, widx, nwork, lane, wave); convert_items(args, lds, CV_D0, CV_D1, widx, nwork, lane, wave); }); \
            if ((L) == 1) IDLE_WORK(S.nwg, { convert_items(args, lds, CV_U1, CV_D0, widx, nwork, lane, wave); convert_items(args, lds, CV_D1, CV_END, widx, nwork, lane, wave); }); \
        } PHASE_END \
        PHASE_BEGIN { \
            pg8::Gemm gm{(const bf16_t*)(args.ws + WS_H), (const bf16_t*)(args.ws + WS_WUP) + (size_t)(L) * 2048 * D_FF2, MTOK, D_FF2, 2048}; \
            pg8::StaticOrder S; S.init(gm.M, gm.N, G, (int)blockIdx.x); \
            pg8::EpiConv E{(float*)(args.ws + WS_ERAW), (float*)(args.ws + WS_ECV), (bf16_t*)(args.ws + WS_ACT), args.in[I_CONVW] + (size_t)(L) * 3 * D_FF2, args.in[I_CONVB] + (size_t)(L) * D_FF2, (LAS float*)(lds + 131072), \
                (const float*)(args.ws + WS_RSF) + (L) * MTOK, (const float*)(args.ws + WS_BIAS) + (size_t)(L) * 3 * D_FF2, (LAS float*)(lds + 139264)}; \
            _Pragma("unroll") for (int rep = 0; rep < GEMM_REP; ++rep) pg8::gemm_phase<pg8::EpiConv, pg8::StaticOrder, true, true>(lds, gm, S, E); \
            if ((L) == 0) IDLE_WORK(S.nwg, gemv_items(args, lds, 96, 128, widx, nwork, tid)); \
        } PHASE_END \
        PHASE_BEGIN { \
            pg8::Gemm gm{(const bf16_t*)(args.ws + WS_ACT), (const bf16_t*)(args.ws + WS_WDN) + (size_t)(L) * D_FF * 2048, MTOK, 2048, D_FF}; \
            pg8::SplitOrder S; S.init(gm.K, G, (int)blockIdx.x, ctl + CW_FIX + 64 * (L)); \
            S.fx_eraw = (const float*)(args.ws + WS_ERAW); S.fx_ecv = (const float*)(args.ws + WS_ECV); S.fx_cw = args.in[I_CONVW] + (size_t)(L) * 3 * D_FF2; S.fx_act = (bf16_t*)(args.ws + WS_ACT); \
            pg8::EpiRes<true, (L) == 0, true> E{(const void*)(args.ws + WS_XRES), (const void*)((const bf16_t*)(args.ws + WS_XRES) + (size_t)NCTX * D_MODEL), (L) == 0 ? (void*)(args.ws + WS_XRES) : (void*)(args.out + O_Y), mod_l + 5 * 2048, (bf16_t*)(args.ws + WS_PART), nullptr, nullptr, nullptr, nullptr}; \
            pg8::gemm_phase<pg8::EpiRes<true, (L) == 0, true>, pg8::SplitOrder, true, true>(lds, gm, S, E); \
        } PHASE_END \
    }
    LAYER_BODY(0)
    LAYER_BODY(1)
    PHASE_BEGIN {
        const int gw = blockIdx.x * 8 + wave, NGW = G * 8; const bf16_t* part = (const bf16_t*)(args.ws + WS_PART); const bf16_t* xr = (const bf16_t*)(args.ws + WS_XRES);
        const float* gfl = (const float*)(args.ws + WS_MOD) + (size_t)3 * 12288 + 5 * 2048;
        for (int m = NCTX + gw; m < MTOK; m += NGW) { const int cond = 1 + ((m - NCTX) >> 10);
            u32x2 xw[8], pw[8][4]; f32x4 gf[8];
#pragma unroll
            for (int j = 0; j < 8; ++j) { const int k = 4 * (64 * j + lane); xw[j] = *(const u32x2*)(xr + (size_t)m * D_MODEL + k); gf[j] = *(const f32x4*)(gfl + (size_t)cond * 12288 + k);
#pragma unroll
                for (int q = 0; q < 4; ++q) pw[j][q] = *(const u32x2*)(part + ((size_t)q * NLAT + (m - NCTX)) * D_MODEL + k); }
#pragma unroll
            for (int j = 0; j < 8; ++j) { const int k = 4 * (64 * j + lane); const f32x4 v = (f32x4){bf_lo(xw[j].x), bf_hi(xw[j].x), bf_lo(xw[j].y), bf_hi(xw[j].y)}; f32x4 ps = (f32x4){0.f, 0.f, 0.f, 0.f};
#pragma unroll
                for (int q = 0; q < 4; ++q) ps += (f32x4){bf_lo(pw[j][q].x), bf_hi(pw[j][q].x), bf_lo(pw[j][q].y), bf_hi(pw[j][q].y)};
                *(f32x4*)(args.out + O_Y + (size_t)m * D_MODEL + k) = v + gf[j] * ps; } }
    } PHASE_END
#undef LAYER_BODY
#undef tid
#undef lane
#undef wave
#undef PHASE_BEGIN
#undef PHASE_END
}

extern "C" void kernel_launch(void* const* d_in, const int* in_sizes, int n_in, void* d_out, int out_size, void* d_ws, size_t ws_size, hipStream_t stream) {
    static int grid = 0;
    if (grid == 0) {
        if (n_in != 34 || ws_size < WS_END) { fprintf(stderr, "kernel_launch: unexpected problem (n_in %d, ws %zu)\n", n_in, ws_size); grid = -1; return; }
        int dev = 0, cus = 0, per_cu = 0;
        if (hipGetDevice(&dev) != hipSuccess || hipDeviceGetAttribute(&cus, hipDeviceAttributeMultiprocessorCount, dev) != hipSuccess) { grid = -1; return; }
        if (hipFuncSetAttribute((const void*)trunk_fwd, hipFuncAttributeMaxDynamicSharedMemorySize, LDS_BYTES) != hipSuccess) { fprintf(stderr, "kernel_launch: hipFuncSetAttribute failed\n"); grid = -1; return; }
        if (hipOccupancyMaxActiveBlocksPerMultiprocessor(&per_cu, (const void*)trunk_fwd, 512, LDS_BYTES) != hipSuccess || per_cu < 1) fprintf(stderr, "kernel_launch: occupancy query says %d blocks per CU\n", per_cu);
        (void)hipGetLastError();
        grid = cus < 256 ? cus : 256;
    }
    if (grid < 0) return;
    (void)hipMemsetAsync((char*)d_ws + WS_CTL, 0, CTL_ZERO_BYTES, stream);
    Args a{};
    for (int i = 0; i < 34; ++i) a.in[i] = (const float*)d_in[i];
    a.out = (float*)d_out; a.ws = (unsigned char*)d_ws; a.ph_lo = 0; a.ph_hi = 15;
    hipLaunchKernelGGL(trunk_fwd, dim3(grid), dim3(512), LDS_BYTES, stream, a);
}
```
